# Optimizing an MI355X kernel written in HIP

```python
import jax, jax.numpy as jnp
from jax import lax
import numpy as np

D_MODEL = 1024
BATCH = 2
SEQ = 16384
DEPTH = 4

GRID_W = 64
N_HEADS = 8
KV_HEADS = 2
HEAD_DIM = 64
Q_PER_KV = N_HEADS // KV_HEADS
AXIS_DIM = HEAD_DIM // 2
ROPE_THETA = 10000.0
Q_BLOCK = 128
Q_DIM = N_HEADS * HEAD_DIM
KV_DIM = KV_HEADS * HEAD_DIM
CONV_CH = D_MODEL // 2
CONV_WIDTH = 31
IN_PROJ_DIM = Q_DIM + 2 * KV_DIM + 2 * CONV_CH
MIX_DIM = Q_DIM + CONV_CH
POOL_WINDOWS = (2, 4, 8, 16)
POOL_GROUPS = len(POOL_WINDOWS)
POOL_GC = D_MODEL // POOL_GROUPS
FFN_DIM = 2816
N_EXPERTS = 8
TOP_K = 2
EXPERT_DIM = 3584
PLE_DIM = 256
EPS = 1e-6

kernel_name = "hybrid_attn_conv_pool_moe_encoder"


def rms_norm(x, g):
    xf = x.astype(jnp.float32)
    y = xf * lax.rsqrt(jnp.mean(xf * xf, axis=-1, keepdims=True) + EPS)
    return (y * g.astype(jnp.float32)).astype(x.dtype)


def layer_norm(x, g, b):
    xf = x.astype(jnp.float32)
    mu = jnp.mean(xf, axis=-1, keepdims=True)
    var = jnp.mean(jnp.square(xf - mu), axis=-1, keepdims=True)
    y = (xf - mu) * lax.rsqrt(var + EPS)
    return (y * g.astype(jnp.float32) + b.astype(jnp.float32)).astype(x.dtype)


def axial_rope_tables(seq):
    rows = seq // GRID_W
    r = jnp.broadcast_to(jnp.arange(rows, dtype=jnp.float32)[:, None], (rows, GRID_W)).reshape(seq)
    c = jnp.broadcast_to(jnp.arange(GRID_W, dtype=jnp.float32)[None, :], (rows, GRID_W)).reshape(seq)
    inv = ROPE_THETA ** (-jnp.arange(0, AXIS_DIM, 2, dtype=jnp.float32) / AXIS_DIM)
    ang = jnp.concatenate([r[:, None] * inv, c[:, None] * inv], axis=-1)
    return jnp.cos(ang)[None, :, None, :], jnp.sin(ang)[None, :, None, :]


def apply_rope(x, cos, sin):
    xf = x.astype(jnp.float32)
    half = HEAD_DIM // 2
    x1, x2 = xf[..., :half], xf[..., half:]
    return jnp.concatenate([x1 * cos - x2 * sin, x2 * cos + x1 * sin], axis=-1).astype(x.dtype)


def block_attention(q, k, v):
    b, s = q.shape[0], q.shape[1]
    nb = s // Q_BLOCK
    qb = q.reshape(b, nb, Q_BLOCK, KV_HEADS, Q_PER_KV, HEAD_DIM).transpose(1, 0, 2, 3, 4, 5)
    scale = HEAD_DIM ** -0.5

    def one_block(q_blk):
        sc = jnp.einsum('bqhgd,bkhd->bhgqk', q_blk, k).astype(jnp.float32) * scale
        pr = jax.nn.softmax(sc, axis=-1).astype(v.dtype)
        return jnp.einsum('bhgqk,bkhd->bqhgd', pr, v)

    out = lax.map(one_block, qb)
    return out.transpose(1, 0, 2, 3, 4, 5).reshape(b, s, Q_DIM)


def attn_conv_mixer(hn, w_in, q_g, k_g, conv_w, conv_b, cln_g, cln_b, w_out, cos, sin):
    b, s, _ = hn.shape
    proj = jnp.einsum('bsd,de->bse', hn, w_in)
    q = proj[..., :Q_DIM].reshape(b, s, N_HEADS, HEAD_DIM)
    k = proj[..., Q_DIM:Q_DIM + KV_DIM].reshape(b, s, KV_HEADS, HEAD_DIM)
    v = proj[..., Q_DIM + KV_DIM:Q_DIM + 2 * KV_DIM].reshape(b, s, KV_HEADS, HEAD_DIM)
    u = proj[..., Q_DIM + 2 * KV_DIM:]
    q = apply_rope(rms_norm(q, q_g), cos, sin)
    k = apply_rope(rms_norm(k, k_g), cos, sin)
    a_out = block_attention(q, k, v)
    u = u[..., :CONV_CH] * jax.nn.sigmoid(u[..., CONV_CH:])
    u = lax.conv_general_dilated(
        u, conv_w[:, None, :], window_strides=(1,),
        padding=[(CONV_WIDTH // 2, CONV_WIDTH // 2)],
        dimension_numbers=('NWC', 'WIO', 'NWC'),
        feature_group_count=CONV_CH) + conv_b
    c_out = jax.nn.silu(layer_norm(u, cln_g, cln_b))
    mix = jnp.concatenate([a_out, c_out], axis=-1)
    return jnp.einsum('bse,ed->bsd', mix, w_out)


def multiscale_pool_mixer(hn, pool_w, pool_scale):
    b, s, d = hn.shape
    hf = hn.astype(jnp.float32)
    cs = jnp.concatenate([jnp.zeros((b, 1, d), jnp.float32), jnp.cumsum(hf, axis=1)], axis=1)
    t = jnp.arange(s)
    outs = []
    for g, w in enumerate(POOL_WINDOWS):
        left = w // 2
        right = w - 1 - left
        lo = jnp.clip(t - left, 0, s - 1)
        hi = jnp.clip(t + right, 0, s - 1)
        seg = cs[..., g * POOL_GC:(g + 1) * POOL_GC]
        win_sum = seg[:, hi + 1] - seg[:, lo]
        cnt = (hi - lo + 1).astype(jnp.float32)[None, :, None]
        outs.append(win_sum / cnt - hf[..., g * POOL_GC:(g + 1) * POOL_GC])
    y = jnp.stack(outs, axis=2).astype(hn.dtype)
    y = jnp.einsum('bsgc,gcd->bsgd', y, pool_w).reshape(b, s, d)
    return y * pool_scale


def swiglu(h, wg, wu, wd):
    return jnp.einsum('bsf,fd->bsd', jax.nn.silu(jnp.einsum('bsd,df->bsf', h, wg)) * jnp.einsum('bsd,df->bsf', h, wu), wd)


def moe_swiglu(h, router_w, wg, wu, wd):
    logits = jnp.einsum('bsd,de->bse', h, router_w).astype(jnp.float32)
    top_v, top_i = lax.top_k(logits, TOP_K)
    top_p = jax.nn.softmax(top_v, axis=-1)
    gates = jnp.einsum('bske,bsk->bse', jax.nn.one_hot(top_i, N_EXPERTS, dtype=jnp.float32), top_p).astype(h.dtype)
    out = jnp.zeros_like(h)
    for e in range(N_EXPERTS):
        out = out + gates[..., e:e + 1] * swiglu(h, wg[e], wu[e], wd[e])
    return out


def setup_inputs(seed: int = 0) -> dict:
    key = jax.random.key(seed)
    ks = iter(jax.random.split(key, 40))
    n_even = (DEPTH + 1) // 2
    n_odd = DEPTH // 2
    f32 = jnp.float32

    def nrm(shape, scale):
        return jax.random.normal(next(ks), shape, f32) * scale

    def gain(shape):
        return 1.0 + 0.05 * jax.random.normal(next(ks), shape, f32)

    return {
        "x": nrm((BATCH, SEQ, D_MODEL), 1.0),
        "p": nrm((DEPTH, BATCH, SEQ, PLE_DIM), 1.0),
        "norm_mix": gain((DEPTH, D_MODEL)),
        "norm_ffn": gain((DEPTH, D_MODEL)),
        "w_in": nrm((n_even, D_MODEL, IN_PROJ_DIM), D_MODEL ** -0.5),
        "q_norm": gain((n_even, HEAD_DIM)),
        "k_norm": gain((n_even, HEAD_DIM)),
        "conv_w": nrm((n_even, CONV_WIDTH, CONV_CH), CONV_WIDTH ** -0.5),
        "conv_b": nrm((n_even, CONV_CH), 0.02),
        "conv_ln_g": gain((n_even, CONV_CH)),
        "conv_ln_b": nrm((n_even, CONV_CH), 0.02),
        "w_out": nrm((n_even, MIX_DIM, D_MODEL), MIX_DIM ** -0.5),
        "ffn_wg": nrm((n_even, D_MODEL, FFN_DIM), D_MODEL ** -0.5),
        "ffn_wu": nrm((n_even, D_MODEL, FFN_DIM), D_MODEL ** -0.5),
        "ffn_wd": nrm((n_even, FFN_DIM, D_MODEL), FFN_DIM ** -0.5),
        "pool_w": nrm((n_odd, POOL_GROUPS, POOL_GC, POOL_GC), POOL_GC ** -0.5),
        "pool_scale": gain((n_odd, D_MODEL)),
        "router_w": nrm((n_odd, D_MODEL, N_EXPERTS), D_MODEL ** -0.5),
        "moe_wg": nrm((n_odd, N_EXPERTS, D_MODEL, EXPERT_DIM), D_MODEL ** -0.5),
        "moe_wu": nrm((n_odd, N_EXPERTS, D_MODEL, EXPERT_DIM), D_MODEL ** -0.5),
        "moe_wd": nrm((n_odd, N_EXPERTS, EXPERT_DIM, D_MODEL), EXPERT_DIM ** -0.5),
        "ple_norm": gain((DEPTH, D_MODEL)),
        "ple_gate_w": nrm((DEPTH, D_MODEL, D_MODEL), D_MODEL ** -0.5),
        "ple_proj": nrm((DEPTH, PLE_DIM, D_MODEL), PLE_DIM ** -0.5),
    }


def reference(x, p, norm_mix, norm_ffn, w_in, q_norm, k_norm, conv_w, conv_b,
              conv_ln_g, conv_ln_b, w_out, ffn_wg, ffn_wu, ffn_wd, pool_w,
              pool_scale, router_w, moe_wg, moe_wu, moe_wd, ple_norm,
              ple_gate_w, ple_proj):
    cos, sin = axial_rope_tables(x.shape[1])
    h = x
    for i in range(DEPTH):
        j = i // 2
        hn = rms_norm(h, norm_mix[i])
        if i % 2 == 0:
            h = h + attn_conv_mixer(hn, w_in[j], q_norm[j], k_norm[j], conv_w[j], conv_b[j],
                                    conv_ln_g[j], conv_ln_b[j], w_out[j], cos, sin)
            h = h + swiglu(rms_norm(h, norm_ffn[i]), ffn_wg[j], ffn_wu[j], ffn_wd[j])
        else:
            h = h + multiscale_pool_mixer(hn, pool_w[j], pool_scale[j])
            h = h + moe_swiglu(rms_norm(h, norm_ffn[i]), router_w[j], moe_wg[j], moe_wu[j], moe_wd[j])
        gate = jax.nn.sigmoid(jnp.einsum('bsd,de->bse', rms_norm(h, ple_norm[i]), ple_gate_w[i]))
        h = h + gate * jnp.einsum('bsk,kd->bsd', p[i], ple_proj[i])
    return h
```

```cpp
#include <hip/hip_runtime.h>
#include <hip/hip_bf16.h>
#include <cstdio>
#include <cstdint>
#include <cmath>

#ifndef MK_ONE_LAUNCH
#define MK_ONE_LAUNCH 1
#endif

constexpr int BATCH = 2, SEQ = 16384, DM = 1024, T = BATCH * SEQ, DEPTH = 4;
constexpr int NH = 8, KVH = 2, HD = 64, QDIM = 512, KVDIM = 128, CONVC = 512, CONVW = 31, INPROJ = 1792;
constexpr int FFN = 2816, NEXP = 8, EXPD = 3584, PLE = 256;
constexpr float EPS = 1e-6f;
constexpr int XROWS = 67584;

__device__ __forceinline__ int opaque_lane() { int l; asm volatile("v_mbcnt_lo_u32_b32 %0, -1, 0\n\tv_mbcnt_hi_u32_b32 %0, -1, %0" : "=v"(l)); return l; }
__device__ __forceinline__ float shx(float v, int mask, int lane) { return __int_as_float(__builtin_amdgcn_ds_bpermute((lane ^ mask) << 2, __float_as_int(v))); }

namespace pg8 {
#define PG8_LAS __attribute__((address_space(3)))
typedef unsigned short bf16_t;
typedef short bf16x8 __attribute__((ext_vector_type(8)));
typedef float f32x4 __attribute__((ext_vector_type(4)));
typedef float f32x2 __attribute__((ext_vector_type(2)));
typedef unsigned u32x4 __attribute__((ext_vector_type(4)));
typedef int v4i_t __attribute__((ext_vector_type(4)));
typedef int v8i_t __attribute__((ext_vector_type(8)));
typedef unsigned u32x2 __attribute__((ext_vector_type(2)));
constexpr int BM = 256, BK = 64, HALF = 128, HTB = HALF * BK * 2, STAGE_BYTES = 8 * HTB, NXCD = 8, WGM = 8;

__host__ __device__ __forceinline__ int lds_byte(int r, int c) { const int st = (r >> 4) * 2 + (c >> 5), rr = r & 15, cc = c & 31, ob = rr * 64 + cc * 2; return st * 1024 + (ob ^ (((ob >> 9) & 1) << 5)); }
__host__ __device__ __forceinline__ void stage_rc(int b, int& R, int& C) { const int st = b / 1024, sb = b % 1024, swz = sb ^ (((sb >> 9) & 1) << 5); R = (st >> 1) * 16 + swz / 64; C = (st & 1) * 32 + (swz % 64) / 2; }
__host__ __device__ __forceinline__ int perm32(int rho) { const int n = rho >> 4, i = rho & 15; return 8 * (i >> 2) + 4 * n + (i & 3); }

struct Unit { const char* a; const char* b; int pm, pn, e; const unsigned* map; const float* srow; int nvalid; const PG8_LAS float* sl  ; };
struct Gemm { int lda, ldb, K; int sa = 0x7F7F7F7F, sb = 0x7F7F7F7F; };

struct GridOrder {
    int nM, nN, nwg, G, c;
    __device__ __forceinline__ void init(int nM_, int nN_, int G_, int c_) { nM = nM_; nN = nN_; nwg = nM * nN; G = G_; c = c_; }
    __device__ __forceinline__ bool tile(int i, int& pm, int& pn) const {
        const long L = (long)i * G + c; if (L >= nwg) return false;
        int wgid = (int)L; { const int q = nwg / NXCD, r = nwg % NXCD, xcd = wgid % NXCD, off = wgid / NXCD; wgid = (xcd < r ? xcd * (q + 1) : r * (q + 1) + (xcd - r) * q) + off; }
        const int nig = WGM * nN, gid = wgid / nig, fm = gid * WGM, gsz = (nM - fm) < WGM ? (nM - fm) : WGM;
        pm = fm + ((wgid % nig) % gsz); pn = (wgid % nig) / gsz; return true;
    }
};

__device__ __forceinline__ unsigned cvt_pk_bf16(float lo, float hi) { unsigned r; asm volatile("v_cvt_pk_bf16_f32 %0, %1, %2" : "=v"(r) : "v"(lo), "v"(hi)); return r; }
__device__ __forceinline__ float fsigmoid(float x) { return __builtin_amdgcn_rcpf(1.0f + __builtin_amdgcn_exp2f(-1.4426950408889634f * x)); }
__device__ __forceinline__ float bf_lo(unsigned w) { return __uint_as_float(w << 16); }
__device__ __forceinline__ float bf_hi(unsigned w) { return __uint_as_float(w & 0xffff0000u); }

typedef f32x4 Acc[2][2][4][2];

__device__ __forceinline__ void row_scales(const float* rowss, int row0, int fq, int lane, float (&s)[2][4]) {
#pragma unroll
    for (int ai = 0; ai < 2; ++ai)
#pragma unroll
        for (int m = 0; m < 4; ++m) {
            const f32x4 v = *(const f32x4*)(rowss + (size_t)(row0 + ai * HALF + m * 16) * 16 + 4 * fq);
            float t = (v[0] + v[1]) + (v[2] + v[3]); t += shx(t, 16, lane); t += shx(t, 32, lane);
            s[ai][m] = __builtin_amdgcn_rsqf(t * (1.0f / 1024.0f) + EPS);
        }
}
__device__ __forceinline__ u32x4 pack8(const f32x4 v0, const f32x4 v1) { u32x4 w; w.x = cvt_pk_bf16(v0[0], v0[1]); w.y = cvt_pk_bf16(v0[2], v0[3]); w.z = cvt_pk_bf16(v1[0], v1[1]); w.w = cvt_pk_bf16(v1[2], v1[3]); return w; }

__device__ __forceinline__ u32x2 pack8_fp8(const f32x4 v0, const f32x4 v1, float sc) {
    unsigned a = 0u, b = 0u;
    a = (unsigned)__builtin_amdgcn_cvt_pk_fp8_f32(v0[0] * sc, v0[1] * sc, (int)a, false); a = (unsigned)__builtin_amdgcn_cvt_pk_fp8_f32(v0[2] * sc, v0[3] * sc, (int)a, true);
    b = (unsigned)__builtin_amdgcn_cvt_pk_fp8_f32(v1[0] * sc, v1[1] * sc, (int)b, false); b = (unsigned)__builtin_amdgcn_cvt_pk_fp8_f32(v1[2] * sc, v1[3] * sc, (int)b, true);
    u32x2 r; r.x = a; r.y = b; return r;
}

constexpr float ATT_C2 = 1.4426950408889634f;
struct EpiInProj {
    static constexpr bool PERM = true;
    bf16_t *Q, *Kb, *Vb, *Gb; const float* rowss; const float* rope  ; const float* gq; const float* gk;
    __device__ __forceinline__ void operator()(const Acc& acc, const Unit& u, int wave) const {
        const int lane = opaque_lane(), wr = wave >> 2, wc = wave & 3, fr = lane & 15, fq = lane >> 4; (void)lane;
        const int row0 = u.pm * BM + wr * 64 + fr, cw = wc * 32 + 8 * fq;
        float s[2][4]; row_scales(rowss, row0, fq, lane, s);
        if (u.pn < 2 || (u.pn == 2 && wc < 2)) {
            const bool isq = u.pn < 2; const float* gain = isq ? gq : gk; const float osc = isq ? 0.5f * ATT_C2 : 0.25f;
            unsigned char* dst = isq ? (unsigned char*)Q + (4 * u.pn + wc) * HD : (unsigned char*)Kb + wc * HD; const int ld = isq ? QDIM : KVDIM;
#pragma unroll
            for (int ai = 0; ai < 2; ++ai)
#pragma unroll
                for (int m = 0; m < 4; ++m) { const size_t row = row0 + ai * HALF + m * 16; const float sc = s[ai][m];
                    float ss = 0.f;
#pragma unroll
                    for (int bj = 0; bj < 2; ++bj)
#pragma unroll
                        for (int n = 0; n < 2; ++n) { const f32x4 x = acc[ai][bj][m][n] * sc; ss += (x[0] * x[0] + x[1] * x[1]) + (x[2] * x[2] + x[3] * x[3]); }
                    ss += shx(ss, 16, lane); ss += shx(ss, 32, lane);
                    const float rs = sc * __builtin_amdgcn_rsqf(ss * (1.0f / HD) + EPS);
                    const float* cp = rope + (size_t)(row & (SEQ - 1)) * 32 + 8 * fq; f32x4 o1[2], o2[2];
#pragma unroll
                    for (int n = 0; n < 2; ++n) { const f32x4 c = *(const f32x4*)(cp + 4 * n), sn = *(const f32x4*)(cp + SEQ * 32 + 4 * n);
                        const f32x4 y1 = acc[ai][0][m][n] * rs * *(const f32x4*)(gain + 8 * fq + 4 * n), y2 = acc[ai][1][m][n] * rs * *(const f32x4*)(gain + 32 + 8 * fq + 4 * n);
                        o1[n] = (y1 * c - y2 * sn) * osc; o2[n] = (y2 * c + y1 * sn) * osc; }
                    *(u32x2*)(dst + row * ld + 8 * fq) = pack8_fp8(o1[0], o1[1], 1.0f); *(u32x2*)(dst + row * ld + 32 + 8 * fq) = pack8_fp8(o2[0], o2[1], 1.0f);
                    asm volatile("" ::: "memory"); }
        } else if (u.pn == 2) {
#pragma unroll
            for (int ai = 0; ai < 2; ++ai)
#pragma unroll
                for (int m = 0; m < 4; ++m) { const int row = row0 + ai * HALF + m * 16; const float sc = s[ai][m];
                    const int sq = row & (SEQ - 1), kv = sq & 63, w = kv & 31, pos = 32 * ((w >> 2) & 1) + (w & 3) + 4 * (w >> 3) + 16 * (kv >> 5);
                    unsigned char* dst = (unsigned char*)Vb + ((size_t)((row / SEQ) * KVH + (wc - 2)) * (SEQ / 64) + (sq >> 6)) * 4096 + pos + (8 * fq) * 64;
#pragma unroll
                    for (int bj = 0; bj < 2; ++bj)
#pragma unroll
                        for (int n = 0; n < 2; ++n) { const f32x4 x = acc[ai][bj][m][n] * sc;
                            const unsigned a = (unsigned)__builtin_amdgcn_cvt_pk_fp8_f32(x[0], x[1], 0, false), b2 = (unsigned)__builtin_amdgcn_cvt_pk_fp8_f32(x[2], x[3], 0, false);
                            unsigned char* d4 = dst + (bj * 32 + n * 4) * 64;
                            d4[0] = (unsigned char)(a & 255u); d4[64] = (unsigned char)((a >> 8) & 255u); d4[128] = (unsigned char)(b2 & 255u); d4[192] = (unsigned char)((b2 >> 8) & 255u); } }
        } else {
#pragma unroll
            for (int ai = 0; ai < 2; ++ai)
#pragma unroll
                for (int m = 0; m < 4; ++m) { const size_t row = row0 + ai * HALF + m * 16; const float sc = s[ai][m]; f32x4 g[2];
#pragma unroll
                    for (int n = 0; n < 2; ++n)
#pragma unroll
                        for (int e = 0; e < 4; ++e) g[n][e] = acc[ai][0][m][n][e] * (sc * __builtin_amdgcn_rcpf(1.0f + __builtin_amdgcn_exp2f(acc[ai][1][m][n][e] * (-1.4426950408889634f * sc))));
                    *(u32x4*)(Gb + row * CONVC + (u.pn - 3) * HALF + cw) = pack8(g[0], g[1]); }
        }
    }
};

constexpr float HID_F8_SCALE = 4.0f;
__device__ __forceinline__ void unpack8(const u32x4 w, f32x4& v0, f32x4& v1) { v0[0] = bf_lo(w.x); v0[1] = bf_hi(w.x); v0[2] = bf_lo(w.y); v0[3] = bf_hi(w.y); v1[0] = bf_lo(w.z); v1[1] = bf_hi(w.z); v1[2] = bf_lo(w.w); v1[3] = bf_hi(w.w); }
__device__ __forceinline__ float ssq8(const f32x4 v0, const f32x4 v1) { return ((v0[0] * v0[0] + v0[1] * v0[1]) + (v0[2] * v0[2] + v0[3] * v0[3])) + ((v1[0] * v1[0] + v1[1] * v1[1]) + (v1[2] * v1[2] + v1[3] * v1[3])); }
struct EpiResid {
    static constexpr bool PERM = true;
    bf16_t* hb; float* rowss; unsigned char* hq;
    __device__ __forceinline__ void operator()(const Acc& acc, const Unit& u, int wave) const {
        const int lane = opaque_lane(), wr = wave >> 2, wc = wave & 3, fr = lane & 15, fq = lane >> 4; (void)lane;
        const int row0 = u.pm * BM + wr * 64 + fr, cw = wc * 32 + 8 * fq;
#pragma unroll
        for (int ai = 0; ai < 2; ++ai)
#pragma unroll
            for (int m = 0; m < 4; ++m) { const size_t row = row0 + ai * HALF + m * 16; float ssq = 0.f;
#pragma unroll
                for (int bj = 0; bj < 2; ++bj) { const size_t off = row * DM + u.pn * 256 + bj * HALF + cw;
                    f32x4 r0, r1; unpack8(*(const u32x4*)(hb + off), r0, r1);
                    const f32x4 v0 = r0 + acc[ai][bj][m][0], v1 = r1 + acc[ai][bj][m][1];
                    *(u32x4*)(hb + off) = pack8(v0, v1); ssq += ssq8(v0, v1);
                    if (hq) *(u32x2*)(hq + off) = pack8_fp8(v0, v1, 1.0f); }
                ssq += shx(ssq, 16, lane); ssq += shx(ssq, 32, lane);
                if (fq == 0) rowss[row * 16 + u.pn * 4 + wc] = ssq;
                asm volatile("" ::: "memory"); }
    }
};
template <bool MOE, bool F8 = false> struct EpiSwiGLU {
    static constexpr bool PERM = true;
    bf16_t* H; int ldh; const float* sc;
    __device__ __forceinline__ void operator()(const Acc& acc, const Unit& u, int wave) const {
        const int lane = opaque_lane(), wr = wave >> 2, wc = wave & 3, fr = lane & 15, fq = lane >> 4; (void)lane;
        const int row0 = u.pm * BM + wr * 64 + fr, cw = wc * 32 + 8 * fq;
        float s[2][4];
        if (MOE) {
#pragma unroll
            for (int ai = 0; ai < 2; ++ai)
#pragma unroll
                for (int m = 0; m < 4; ++m) s[ai][m] = u.sl[wr * 64 + fr + ai * HALF + m * 16];
        } else row_scales(sc, row0, fq, lane, s);
#pragma unroll
        for (int ai = 0; ai < 2; ++ai)
#pragma unroll
            for (int m = 0; m < 4; ++m) { const size_t row = row0 + ai * HALF + m * 16; const float sv = s[ai][m], nsv = -1.4426950408889634f * sv;
                const float c = __builtin_amdgcn_rcpf((F8 ? HID_F8_SCALE : 1.0f) * sv * sv); f32x4 g[2];
#pragma unroll
                for (int n = 0; n < 2; ++n)
                    { const f32x4 pr = acc[ai][0][m][n] * acc[ai][1][m][n]; const f32x4 tt = acc[ai][0][m][n] * nsv; f32x4 ex, rc;
#pragma unroll
                      for (int e = 0; e < 4; ++e) ex[e] = __builtin_amdgcn_exp2f(tt[e]);
                      const f32x4 den = ex * c + c;
#pragma unroll
                      for (int e = 0; e < 4; ++e) rc[e] = __builtin_amdgcn_rcpf(den[e]);
                      g[n] = pr * rc; }
                if (F8) *(u32x2*)((unsigned char*)H + row * ldh + u.pn * HALF + cw) = pack8_fp8(g[0], g[1], 1.0f);
                else *(u32x4*)(H + row * ldh + u.pn * HALF + cw) = pack8(g[0], g[1]); }
    }
};
struct EpiStore {
    static constexpr bool PERM = true;
    bf16_t* O; int ldc;
    __device__ __forceinline__ void operator()(const Acc& acc, const Unit& u, int wave) const {
        const int lane = opaque_lane(), wr = wave >> 2, wc = wave & 3, fr = lane & 15, fq = lane >> 4; (void)lane;
        const int row0 = u.pm * BM + wr * 64 + fr, cw = wc * 32 + 8 * fq;
#pragma unroll
        for (int ai = 0; ai < 2; ++ai)
#pragma unroll
            for (int m = 0; m < 4; ++m) { const size_t row = row0 + ai * HALF + m * 16;
#pragma unroll
                for (int bj = 0; bj < 2; ++bj) *(u32x4*)(O + row * ldc + u.pn * 256 + bj * HALF + cw) = pack8(acc[ai][bj][m][0], acc[ai][bj][m][1]); }
    }
};
template <bool FINAL> struct EpiPle {
    static constexpr bool PERM = true;
    const bf16_t* hin; bf16_t* hout; float* fout; float* rowss_out; const float* rowss_in; const bf16_t* pple;
    __device__ __forceinline__ void operator()(const Acc& acc, const Unit& u, int wave) const {
        const int lane = opaque_lane(), wr = wave >> 2, wc = wave & 3, fr = lane & 15, fq = lane >> 4; (void)lane;
        const int row0 = u.pm * BM + wr * 64 + fr, cw = wc * 32 + 8 * fq;
        float s[2][4]; row_scales(rowss_in, row0, fq, lane, s);
#pragma unroll
        for (int ai = 0; ai < 2; ++ai)
#pragma unroll
            for (int m = 0; m < 4; ++m) { const size_t row = row0 + ai * HALF + m * 16; const float sv = s[ai][m]; float ssq = 0.f;
#pragma unroll
                for (int bj = 0; bj < 2; ++bj) { const size_t off = row * DM + u.pn * 256 + bj * HALF + cw;
                    f32x4 r0, r1, p0, p1; unpack8(*(const u32x4*)(hin + off), r0, r1); unpack8(*(const u32x4*)(pple + off), p0, p1);
                    const float nsv = -1.4426950408889634f * sv; const f32x4 a0 = acc[ai][bj][m][0] * nsv, a1 = acc[ai][bj][m][1] * nsv;
                    f32x4 v0, v1;
#pragma unroll
                    for (int e = 0; e < 4; ++e) { v0[e] = r0[e] + __builtin_amdgcn_rcpf(1.0f + __builtin_amdgcn_exp2f(a0[e])) * p0[e]; v1[e] = r1[e] + __builtin_amdgcn_rcpf(1.0f + __builtin_amdgcn_exp2f(a1[e])) * p1[e]; }
                    if (FINAL) { *(f32x4*)(fout + off) = v0; *(f32x4*)(fout + off + 4) = v1; }
                    else { *(u32x4*)(hout + off) = pack8(v0, v1); ssq += ssq8(v0, v1); } }
                if (!FINAL) { ssq += shx(ssq, 16, lane); ssq += shx(ssq, 32, lane);
                    if (fq == 0) rowss_out[row * 16 + u.pn * 4 + wc] = ssq; }
                asm volatile("" ::: "memory"); }
    }
};

template <class Epi, class Sched, bool GATHER = false, bool FP8 = false>
__device__ __forceinline__ void gemm_phase(PG8_LAS unsigned char* lds, const Gemm g, const Sched& S, const Epi& E, const int wid) {
    const int lane = opaque_lane(), tid = wid * 64 + lane, wr = wid >> 2, wc = wid & 3, fr = lane & 15, fq = lane >> 4;
    const int K = g.K, nt = K / BK;
    unsigned voffA[2], voffB[2]; int gR[2]; unsigned gC[2];
#pragma unroll
    for (int i = 0; i < 2; ++i) { int R, C; stage_rc(tid * 16 + i * 8192, R, C); const int Rb = Epi::PERM ? ((R & ~31) + perm32(R & 31)) : R;
        voffA[i] = (unsigned)(R * g.lda + C) * 2u; voffB[i] = (unsigned)(Rb * g.ldb + C) * 2u; gR[i] = R; gC[i] = (unsigned)C * 2u; }
    unsigned vC0[2], vC1[2], vN0[2], vN1[2];
    constexpr int IDX_OFF = 132096;
#define PG8_IDMA(u_, buf) do { if (wid == 0) __builtin_amdgcn_global_load_lds((const unsigned*)((const char*)(u_).map + lane * 16), (PG8_LAS unsigned*)(lds + IDX_OFF + (buf) * 1024), 16, 0, 0); } while (0)
#define PG8_SDMA(u_, buf) do { if (wid == 1) __builtin_amdgcn_global_load_lds((const unsigned*)((const char*)(u_).srow + lane * 16), (PG8_LAS unsigned*)(lds + IDX_OFF + 2048 + (buf) * 1024), 16, 0, 0); } while (0)
#define PG8_GIDX(u_, buf, v0, v1) do { asm volatile("" ::: "memory"); const PG8_LAS unsigned* ib_ = (const PG8_LAS unsigned*)(lds + IDX_OFF + (buf) * 1024); \
        _Pragma("unroll") for (int _i = 0; _i < 2; ++_i) {   \
        v0[_i] = ib_[gR[_i]] * (unsigned)(g.lda * 2) + gC[_i]; v1[_i] = ib_[gR[_i] + HALF] * (unsigned)(g.lda * 2) + gC[_i]; } } while (0)
#define PG8_STA(bufoff, gbase, h, nx) do { if constexpr (GATHER) { unsigned v_[2]; v_[0] = (nx) ? vN##h[0] : vC##h[0]; v_[1] = (nx) ? vN##h[1] : vC##h[1]; PG8_STAGE(bufoff, gbase, v_); } \
        else { PG8_STAGE(bufoff, (gbase) + (h) * hstepA, voffA); } } while (0)
    const size_t kstep = (size_t)(BK * 2);
    const size_t hstepA = (size_t)HALF * g.lda * 2, hstepB = (size_t)HALF * g.ldb * 2;
    const unsigned ldsw = (unsigned)wid * 1024u;
    const int aoff = lds_byte(wr * 64 + fr, fq * 8), boff = lds_byte(wc * 32 + fr, fq * 8);
#define PG8_SA(b, h) (((b) * 2 + (h)) * HTB)
#define PG8_SB(b, h) ((4 + (b) * 2 + (h)) * HTB)
#define PG8_STAGE(bufoff, gbase, voff) do { _Pragma("unroll") for (int _i = 0; _i < 2; ++_i) \
        __builtin_amdgcn_global_load_lds((const unsigned*)((const char*)(gbase) + (voff)[_i]), (PG8_LAS unsigned*)(lds + (bufoff) + ldsw + _i * 8192), 16, 0, 0); } while (0)
#define PG8_LDA(dst, b, h) do { _Pragma("unroll") for (int m = 0; m < 4; ++m) _Pragma("unroll") for (int k = 0; k < 2; ++k) dst[m][k] = *(const PG8_LAS bf16x8*)(lds + PG8_SA(b, h) + aoff + m * 2048 + k * 1024); } while (0)
#define PG8_LDB(dst, b, h) do { _Pragma("unroll") for (int n = 0; n < 2; ++n) _Pragma("unroll") for (int k = 0; k < 2; ++k) dst[n][k] = *(const PG8_LAS bf16x8*)(lds + PG8_SB(b, h) + boff + n * 2048 + k * 1024); } while (0)
#define PG8_CAT8(lo, hi) __builtin_shufflevector(__builtin_bit_cast(v4i_t, lo), __builtin_bit_cast(v4i_t, hi), 0, 1, 2, 3, 4, 5, 6, 7)
#define PG8_MMA(ai, bj, At, Bt) do { __builtin_amdgcn_s_setprio(1); _Pragma("unroll") for (int m = 0; m < 4; ++m) _Pragma("unroll") for (int n = 0; n < 2; ++n) { \
        if constexpr (FP8) { const v8i_t b8_ = PG8_CAT8(Bt[n][0], Bt[n][1]), a8_ = PG8_CAT8(At[m][0], At[m][1]);   \
            asm volatile("v_mfma_scale_f32_16x16x128_f8f6f4 %0, %1, %2, %0, %3, %4 op_sel_hi:[0,0,0]" : "+v"(acc[ai][bj][m][n]) : "v"(b8_), "v"(a8_), "v"(sbv), "v"(sav)); } \
        else { _Pragma("unroll") for (int k = 0; k < 2; ++k) acc[ai][bj][m][n] = __builtin_amdgcn_mfma_f32_16x16x32_bf16(Bt[n][k], At[m][k], acc[ai][bj][m][n], 0, 0, 0); } } \
        __builtin_amdgcn_s_setprio(0); } while (0)
#define PG8_WAIT_V(n) asm volatile("s_waitcnt vmcnt(" #n ")" ::: "memory")
#define PG8_WAIT_L(n) asm volatile("s_waitcnt lgkmcnt(" #n ")" ::: "memory")
#define PG8_BAR __builtin_amdgcn_s_barrier()
#define PG8_SCHED __builtin_amdgcn_sched_barrier(0)
    int sav = g.sa, sbv = g.sb; if constexpr (FP8) { asm volatile("" : "+v"(sav), "+v"(sbv)); }
    Unit cur, nxt; int ui = 0;
    if (!S.next(0, cur)) return;
    Acc acc;
#pragma unroll
    for (int a = 0; a < 2; ++a)
#pragma unroll
        for (int b = 0; b < 2; ++b)
#pragma unroll
            for (int m = 0; m < 4; ++m)
#pragma unroll
                for (int n = 0; n < 2; ++n) acc[a][b][m][n] = (f32x4){0.f, 0.f, 0.f, 0.f};
    bf16x8 At[4][2], B0[2][2], B1[2][2];
    const char* cA = cur.a; const char* cB = cur.b;
    if constexpr (GATHER) { PG8_IDMA(cur, 0); PG8_SDMA(cur, 0); PG8_WAIT_V(0); PG8_BAR; PG8_GIDX(cur, 0, vC0, vC1); cur.sl = (const PG8_LAS float*)(lds + IDX_OFF + 2048); }
    PG8_STAGE(PG8_SB(0, 0), cB, voffB); PG8_STAGE(PG8_SB(0, 1), cB + hstepB, voffB); PG8_STA(PG8_SA(0, 0), cA, 0, false); PG8_STA(PG8_SA(0, 1), cA, 1, false);
    if (wr == 1) PG8_BAR;
    PG8_WAIT_V(2); PG8_BAR;
    PG8_STAGE(PG8_SB(1, 0), cB + kstep, voffB); PG8_STA(PG8_SA(1, 0), cA + kstep, 0, false); PG8_STAGE(PG8_SB(1, 1), cB + hstepB + kstep, voffB);
    PG8_WAIT_V(6); PG8_BAR;
    for (;;) {
        const bool has_next = S.next(ui + 1, nxt);
        const char* nA = has_next ? nxt.a : cA; const char* nB = has_next ? nxt.b : cB;
        if constexpr (GATHER) { if (has_next) { PG8_IDMA(nxt, (ui + 1) & 1); } vN0[0] = vC0[0]; vN0[1] = vC0[1]; vN1[0] = vC1[0]; vN1[1] = vC1[1]; }
        for (int t = 0; t < nt; t += 2) {
            const bool last = (t == nt - 2);
            const char* a1 = cA + (size_t)(t + 1) * kstep;
            const char* a2 = last ? nA : cA + (size_t)(t + 2) * kstep; const char* b2 = last ? nB : cB + (size_t)(t + 2) * kstep;
            const char* a3 = a2 + kstep; const char* b3 = b2 + kstep;
            asm volatile("" : "+s"(a1), "+s"(a2), "+s"(a3), "+s"(b2), "+s"(b3));
            if constexpr (GATHER) { if (last && has_next) { PG8_GIDX(nxt, (ui + 1) & 1, vN0, vN1); } }
            PG8_LDB(B0, 0, 0); PG8_LDB(B1, 0, 1); PG8_SCHED; PG8_LDA(At, 0, 0); PG8_STA(PG8_SA(1, 1), a1, 1, false);
            PG8_WAIT_V(8); PG8_WAIT_L(0); PG8_BAR;
            if constexpr (GATHER) { if (t == 0 && has_next) { PG8_SDMA(nxt, (ui + 1) & 1); } }
            PG8_MMA(0, 0, At, B0); PG8_MMA(0, 1, At, B1); PG8_BAR; PG8_SCHED;
            PG8_LDA(At, 0, 1); PG8_STAGE(PG8_SB(0, 0), b2, voffB); PG8_STAGE(PG8_SB(0, 1), b2 + hstepB, voffB); PG8_STA(PG8_SA(0, 0), a2, 0, last);
            PG8_WAIT_V(8); PG8_WAIT_L(0); PG8_BAR; PG8_MMA(1, 0, At, B0); PG8_MMA(1, 1, At, B1); PG8_BAR; PG8_SCHED;
            PG8_LDB(B0, 1, 0); PG8_LDB(B1, 1, 1); PG8_SCHED; PG8_LDA(At, 1, 0); PG8_STA(PG8_SA(0, 1), a2, 1, last);
            PG8_WAIT_V(8); PG8_WAIT_L(0); PG8_BAR; PG8_MMA(0, 0, At, B0); PG8_MMA(0, 1, At, B1); PG8_BAR; PG8_SCHED;
            PG8_LDA(At, 1, 1); PG8_STAGE(PG8_SB(1, 0), b3, voffB); PG8_STAGE(PG8_SB(1, 1), b3 + hstepB, voffB); PG8_STA(PG8_SA(1, 0), a3, 0, last);
            PG8_WAIT_V(8); PG8_WAIT_L(0); PG8_BAR; PG8_MMA(1, 0, At, B0); PG8_MMA(1, 1, At, B1); PG8_BAR; PG8_SCHED;
        }
        if (wr == 0) PG8_BAR;
        if constexpr (FP8) { asm volatile("s_nop 15\n\ts_nop 7" ::: "memory"); }
        E(acc, cur, wid);
        if (!has_next) break;
#pragma unroll
        for (int a = 0; a < 2; ++a)
#pragma unroll
            for (int b = 0; b < 2; ++b)
#pragma unroll
                for (int m = 0; m < 4; ++m)
#pragma unroll
                    for (int n = 0; n < 2; ++n) acc[a][b][m][n] = (f32x4){0.f, 0.f, 0.f, 0.f};
        cur = nxt; cA = nA; cB = nB; ++ui;
        if constexpr (GATHER) cur.sl = (const PG8_LAS float*)(lds + IDX_OFF + 2048 + (ui & 1) * 1024);
        if constexpr (GATHER) { vC0[0] = vN0[0]; vC0[1] = vN0[1]; vC1[0] = vN1[0]; vC1[1] = vN1[1]; }
        if (wr == 1) PG8_BAR;
    }
    PG8_WAIT_V(0);
    PG8_BAR;
#undef PG8_SA
#undef PG8_SB
#undef PG8_STAGE
#undef PG8_STA
#undef PG8_GIDX
#undef PG8_SDMA
#undef PG8_IDMA
#undef PG8_LDA
#undef PG8_LDB
#undef PG8_MMA
#undef PG8_CAT8
#undef PG8_WAIT_V
#undef PG8_WAIT_L
#undef PG8_BAR
#undef PG8_SCHED
}
}

namespace attn_body {
using bf16 = __hip_bfloat16;
using bf16x8 = __attribute__((ext_vector_type(8))) short;
using s16x4 = __attribute__((ext_vector_type(4))) short;
using f32x16 = __attribute__((ext_vector_type(16))) float;
using u32x4 = __attribute__((ext_vector_type(4))) unsigned;
constexpr int ASEQ = SEQ, D = 64, QP = QDIM, KP = KVDIM, OP = DM;
constexpr int NW = 8, QBLK = 32, QB = QBLK * NW, KVBLK = 64;
__device__ __forceinline__ int crow(int r, int hi) { return (r & 3) + 8 * (r >> 2) + 4 * hi; }
#define SBAR() __builtin_amdgcn_sched_barrier(0)
constexpr int NSLOT = 3, SLOTB = 8192;
constexpr int LDS_K = 0, LDS_V = NSLOT * SLOTB, LDS_WS = 2 * NSLOT * SLOTB, LDS_OST = LDS_WS + NW * 64 * 4, LDS_BYTES = LDS_OST + NW * 4096;
constexpr float C2 = pg8::ATT_C2;
__device__ __forceinline__ void glds16(const void* gsrc, unsigned lds_dst) { unsigned keep;
  asm volatile("s_mov_b32 %0, m0\n\ts_mov_b32 m0, %2\n\ts_nop 0\n\tglobal_load_lds_dwordx4 %1, off\n\ts_mov_b32 m0, %0" : "=&s"(keep) : "v"(gsrc), "s"(lds_dst) : "memory"); }
__device__ __forceinline__ float max3f(float a, float b, float c) { float r; asm("v_max3_f32 %0, %1, %2, %3" : "=v"(r) : "v"(a), "v"(b), "v"(c)); return r; }
__device__ __forceinline__ float max2f(float a, float b) { float r; asm("v_max_f32_e32 %0, %1, %2" : "=v"(r) : "v"(a), "v"(b)); return r; }
__device__ __forceinline__ float fadd_s(float a, float b) { float r; asm("v_add_f32_e32 %0, %1, %2" : "=v"(r) : "v"(a), "v"(b)); return r; }
__device__ __forceinline__ float fsub_s(float a, float b) { float r; asm("v_sub_f32_e32 %0, %1, %2" : "=v"(r) : "v"(a), "v"(b)); return r; }
typedef float f32x2_t __attribute__((ext_vector_type(2))); typedef __bf16 bf16x2_t __attribute__((ext_vector_type(2)));
__device__ __forceinline__ unsigned cvtpk_s(float lo, float hi) { f32x2_t v = {lo, hi}; bf16x2_t b = __builtin_convertvector(v, bf16x2_t); return __builtin_bit_cast(unsigned, b); }
#define WAIT_BAR(N) asm volatile("s_waitcnt vmcnt(" #N ") lgkmcnt(0)\n\ts_barrier" ::: "memory")

__device__ __forceinline__ void qkt(f32x16& p0, f32x16& p1, const char* Kslot, const bf16x8* qr, const f32x16& negm, int r32, int hi) {
  const char* kb = Kslot + hi * 1024 + r32 * 16;
  #pragma unroll
  for (int d0 = 0; d0 < 4; ++d0) {
    const bf16x8 b0 = *reinterpret_cast<const bf16x8*>(kb + d0 * 2048);
    const bf16x8 b1 = *reinterpret_cast<const bf16x8*>(kb + d0 * 2048 + 512);
    if (d0 == 0) { p0 = __builtin_amdgcn_mfma_f32_32x32x16_bf16(b0, qr[0], negm, 0, 0, 0); p1 = __builtin_amdgcn_mfma_f32_32x32x16_bf16(b1, qr[0], negm, 0, 0, 0); }
    else { p0 = __builtin_amdgcn_mfma_f32_32x32x16_bf16(b0, qr[d0], p0, 0, 0, 0); p1 = __builtin_amdgcn_mfma_f32_32x32x16_bf16(b1, qr[d0], p1, 0, 0, 0); } }
}
typedef __attribute__((address_space(3))) const char* lds_cptr;
typedef short v4i16_t __attribute__((ext_vector_type(4)));
__device__ __forceinline__ void kload8(bf16x8* kf, lds_cptr kp) {
  kf[0] = *(const __attribute__((address_space(3))) bf16x8*)(kp);        kf[1] = *(const __attribute__((address_space(3))) bf16x8*)(kp + 512);
  kf[2] = *(const __attribute__((address_space(3))) bf16x8*)(kp + 2048); kf[3] = *(const __attribute__((address_space(3))) bf16x8*)(kp + 2560);
  kf[4] = *(const __attribute__((address_space(3))) bf16x8*)(kp + 4096); kf[5] = *(const __attribute__((address_space(3))) bf16x8*)(kp + 4608);
  kf[6] = *(const __attribute__((address_space(3))) bf16x8*)(kp + 6144); kf[7] = *(const __attribute__((address_space(3))) bf16x8*)(kp + 6656);
}
__device__ __forceinline__ void kload2(bf16x8* kf, lds_cptr kp, int j) { kf[2 * j] = *(const __attribute__((address_space(3))) bf16x8*)(kp + j * 2048); kf[2 * j + 1] = *(const __attribute__((address_space(3))) bf16x8*)(kp + j * 2048 + 512); }
__device__ __forceinline__ s16x4 vtr(lds_cptr p) { return __builtin_bit_cast(s16x4, __builtin_amdgcn_ds_read_tr16_b64_v4i16((__attribute__((address_space(3))) v4i16_t*)p)); }
__device__ __forceinline__ float rowmax(const f32x16& p0, const f32x16& p1) {
  float a = max3f(p0[0], p0[1], p1[0]), b = max3f(p0[2], p0[3], p1[1]); a = max3f(a, p1[2], p1[3]);
  #pragma unroll
  for (int r = 4; r < 16; r += 4) { a = max3f(a, p0[r], p0[r + 1]); b = max3f(b, p0[r + 2], p0[r + 3]); a = max3f(a, p1[r], p1[r + 1]); b = max3f(b, p1[r + 2], p1[r + 3]); }
  const float m = max2f(a, b);
  auto rr = __builtin_amdgcn_permlane32_swap(__float_as_uint(m), __float_as_uint(m), false, false);
  return max2f(__uint_as_float(rr[0]), __uint_as_float(rr[1]));
}
__device__ __forceinline__ void pv(f32x16* o, int vb, bf16x8 pa0, bf16x8 pa1, bf16x8 pa2, bf16x8 pa3) {
  #pragma unroll
  for (int d0 = 0; d0 < 2; ++d0) { s16x4 lo[4], hi[4];
    #pragma unroll
    for (int ks = 0; ks < 4; ++ks) {
      asm volatile("ds_read_b64_tr_b16 %0,%1 offset:%c2" : "=&v"(lo[ks]) : "v"(vb), "i"(d0 * 4096 + ks * 1024) : "memory");
      asm volatile("ds_read_b64_tr_b16 %0,%1 offset:%c2" : "=&v"(hi[ks]) : "v"(vb), "i"(d0 * 4096 + ks * 1024 + 512) : "memory"); }
    asm volatile("s_waitcnt lgkmcnt(0)" ::: "memory"); SBAR();
    #define PK(k) (bf16x8){lo[k][0], lo[k][1], lo[k][2], lo[k][3], hi[k][0], hi[k][1], hi[k][2], hi[k][3]}
    o[d0] = __builtin_amdgcn_mfma_f32_32x32x16_bf16(pa0, PK(0), o[d0], 0, 0, 0);
    o[d0] = __builtin_amdgcn_mfma_f32_32x32x16_bf16(pa1, PK(1), o[d0], 0, 0, 0);
    o[d0] = __builtin_amdgcn_mfma_f32_32x32x16_bf16(pa2, PK(2), o[d0], 0, 0, 0);
    o[d0] = __builtin_amdgcn_mfma_f32_32x32x16_bf16(pa3, PK(3), o[d0], 0, 0, 0);
    #undef PK
  }
}
#define ATTN_STORE16(p, v) (*(u32x4*)(p) = (v))
typedef int v4i_ __attribute__((ext_vector_type(4))); typedef int v8i_ __attribute__((ext_vector_type(8)));
template <int THRL> __device__ __forceinline__ void attn_unit(int b, int h, int qb, const unsigned char* Q8, const unsigned char* __restrict__ K8, const unsigned char* __restrict__ VT, bf16* O, char* shm, const int wid) {
  const int lane = opaque_lane(), r32 = lane & 31, hi = lane >> 5;
  const long rowbase = (long)b * ASEQ; const int q0 = qb * QB; const int kvh = h >> 2;
  const unsigned char* Qw = Q8 + (size_t)(rowbase + q0 + wid * QBLK) * QP + h * D;
  const unsigned char* Kh = K8 + (size_t)rowbase * KP + kvh * D; const unsigned char* Vh = VT + (size_t)(b * KVH + kvh) * (ASEQ / KVBLK) * 4096;
  const unsigned lds0 = (unsigned)(uintptr_t)shm;
  float* wsf = (float*)(shm + LDS_WS) + wid * 64;
  static_assert(THRL < 0, "the lazy-rescale path needs the one-barrier-per-tile loop");
  const int vL = wid * 64 + lane, vrow = vL >> 2, vsw = ((vL & 3) ^ ((vrow >> 1) & 3)) * 16;
  const unsigned char* vsrc = Vh + vrow * 64 + vsw;
  const unsigned char* ksrc = Kh + (size_t)vrow * KP + vsw;
  const unsigned kdst = lds0 + LDS_K + wid * 1024, vdst = lds0 + LDS_V + wid * 1024;
  #define DMA_K(T_, slot) glds16(ksrc + (long)(T_) * 2 * KVBLK * KP, (unsigned)__builtin_amdgcn_readfirstlane(kdst + (slot)))
  #define DMA_V(T_, slot) glds16(vsrc + (long)(T_) * 8192, (unsigned)__builtin_amdgcn_readfirstlane(vdst + (slot)))
  v4i_ kq0, kq1, kq2, kq3;
  const lds_cptr shm3 = (lds_cptr)shm; const int vc0 = (2 * hi) ^ ((r32 >> 1) & 3); const lds_cptr vp0 = shm3 + LDS_V + r32 * 64 + vc0 * 16, vp1 = shm3 + LDS_V + r32 * 64 + (vc0 ^ 1) * 16; const lds_cptr kp0 = vp0 + (LDS_K - LDS_V), kp1 = vp1 + (LDS_K - LDS_V);
  constexpr int NT = ASEQ / KVBLK;
  DMA_K(0, 0); DMA_V(0, 0); DMA_K(1, SLOTB);
  const v8i_ qv = __builtin_shufflevector(*reinterpret_cast<const v4i_*>(Qw + (size_t)r32 * QP + hi * 32), *reinterpret_cast<const v4i_*>(Qw + (size_t)r32 * QP + hi * 32 + 16), 0, 1, 2, 3, 4, 5, 6, 7);
  #define KQR(i, sl) do { kq##i = *(const __attribute__((address_space(3))) v4i_*)((((i) & 1) ? kp1 : kp0) + (sl) + ((i) >> 1) * 2048); } while (0)
  #define KCAT(a, b) __builtin_shufflevector(a, b, 0, 1, 2, 3, 4, 5, 6, 7)
  #define MFQK(a, b, c) __builtin_amdgcn_mfma_scale_f32_32x32x64_f8f6f4(a, b, c, 0, 0, 0, 0, 0, 0)
  float mhat = 0.f; f32x16 o[2], osum = f32x16{}; o[0] = f32x16{}; o[1] = f32x16{}; v8i_ vones; _Pragma("unroll") for (int r = 0; r < 8; ++r) vones[r] = 0x38383838; asm volatile("" : "+v"(vones)); f32x16 negm; _Pragma("unroll") for (int r = 0; r < 16; ++r) negm[r] = -2.0f; asm volatile("" : "+v"(negm));
  #define CMASK(P0, P1, t) do {} while (0)
  bool resc = false;
  #define START(P0, P1) do { const float rm = rowmax(P0, P1); resc = false; \
    { const float dl = rm; mhat = fadd_s(mhat, dl); \
      _Pragma("unroll") for (int r = 0; r < 16; ++r) { P0[r] = fsub_s(P0[r], dl); P1[r] = fsub_s(P1[r], dl); } \
      _Pragma("unroll") for (int r = 0; r < 16; ++r) negm[r] = -mhat; asm volatile("" : "+v"(negm)); } \
    _Pragma("unroll") for (int r = 0; r < 16; ++r) P0[r] = __builtin_amdgcn_exp2f(P0[r]); } while (0)
  #define RESC() do { if (THRL >= 0 && resc) { asm volatile("s_waitcnt lgkmcnt(0)" ::: "memory"); \
      _Pragma("unroll") for (int d_ = 0; d_ < 2; ++d_) _Pragma("unroll") for (int r = 0; r < 16; ++r) o[d_][r] *= wsf[crow(r, hi)]; } } while (0)
  f32x16 pA0, pA1, pB0, pB1;
  int s0 = 2 * SLOTB, s1 = 0, s2 = SLOTB;
  #define ROT() do { const int s_ = s0; s0 = s1; s1 = s2; s2 = s_; } while (0)
  DMA_K(2, 2 * SLOTB); DMA_V(1, SLOTB);
  WAIT_BAR(2);
  KQR(0, 0); KQR(1, 0); KQR(2, 0); KQR(3, 0); pA0 = MFQK(KCAT(kq0, kq1), qv, negm); pA1 = MFQK(KCAT(kq2, kq3), qv, negm); CMASK(pA0, pA1, 0);
  if constexpr (THRL >= 0) { START(pA0, pA1); } else { _Pragma("unroll") for (int r = 0; r < 16; ++r) pA0[r] = __builtin_amdgcn_exp2f(pA0[r]); }
  _Pragma("unroll") for (int r = 0; r < 16; ++r) pA1[r] = __builtin_amdgcn_exp2f(pA1[r]);
  KQR(0, 4096); KQR(1, 4096); KQR(2, 4096); KQR(3, 4096);
  v4i_ vq0, vq1, vq2, vq3; unsigned pq0 = 0u, pq1 = 0u, pq2 = 0u, pq3 = 0u, pq4 = 0u, pq5 = 0u, pq6 = 0u, pq7 = 0u;
  #define PK8(P, B, old, hw) (unsigned)__builtin_amdgcn_cvt_pk_bf8_f32(P[B], P[(B) + 1], (int)(old), hw)
  #define PQV() (v8i_){(int)pq0, (int)pq1, (int)pq2, (int)pq3, (int)pq4, (int)pq5, (int)pq6, (int)pq7}
  #define VCAT(a, b) __builtin_shufflevector(a, b, 0, 1, 2, 3, 4, 5, 6, 7)
  #define MFMA8(a, b, c) __builtin_amdgcn_mfma_scale_f32_32x32x64_f8f6f4(a, b, c, 1  , 0  , 0, 0, 0, 0)
  #define VQR(i, sl) do { vq##i = *(const __attribute__((address_space(3))) v4i_*)((((i) & 1) ? vp1 : vp0) + (sl) + ((i) >> 1) * 2048); } while (0)
  #define PIN(x) asm volatile("" : "+v"(x))
  #define MX3(a, b, c) __builtin_fmaxf(__builtin_fmaxf((a), (b)), (c))
  #define GAPA(MF, A0, A1, A2, A3, W0, W1, PW) do { MF; W0; W1; PIN(PW); SBAR(); } while (0)
  #define EX(v) __builtin_amdgcn_exp2f(v)
  #define GAPB(MF, X, B) do { MF; X[B] = EX(X[B]); X[B + 1] = EX(X[B + 1]); X[B + 2] = EX(X[B + 2]); X[B + 3] = EX(X[B + 3]); PIN(X); SBAR(); } while (0)
  #define EXG(X, B) do { X[B] = EX(X[B]); X[B + 1] = EX(X[B + 1]); X[B + 2] = EX(X[B + 2]); X[B + 3] = EX(X[B + 3]); PIN(X); SBAR(); } while (0)
  #define KRD(G, j) do { if (G) { KQR(j, ko_); SBAR(); } } while (0)
  #define STEP(C0, C1, P0, P1, VO, KO, DMAS, GL) do { SBAR(); const int vo_ = (VO), ko_ = (KO); (void)ko_; \
    VQR(0, vo_); SBAR(); \
    C0 = MFQK(KCAT(kq0, kq1), qv, negm); SBAR(); \
    GAPA((void)0, P0[2], P0[3], P0[4], P0[5],     pq0 = PK8(P0, 0, pq0, false), pq0 = PK8(P0, 2, pq0, true), pq0); \
    VQR(1, vo_); SBAR(); GAPA((void)0, P0[6], P0[7], P0[8], P0[9],     pq1 = PK8(P0, 4, pq1, false), pq1 = PK8(P0, 6, pq1, true), pq1); \
    VQR(2, vo_); SBAR(); GAPA((void)0, P0[10], P0[11], P0[12], P0[13], pq2 = PK8(P0, 8, pq2, false), pq2 = PK8(P0, 10, pq2, true), pq2); \
    VQR(3, vo_); SBAR(); GAPA((void)0, P0[14], P0[15], P1[0], P1[1],   pq3 = PK8(P0, 12, pq3, false), pq3 = PK8(P0, 14, pq3, true), pq3); \
    C1 = MFQK(KCAT(kq2, kq3), qv, negm); SBAR(); \
    GAPA((void)0, P1[2], P1[3], P1[4], P1[5],     pq4 = PK8(P1, 0, pq4, false), pq4 = PK8(P1, 2, pq4, true), pq4); \
    GAPA((void)0, P1[6], P1[7], P1[8], P1[9],     pq5 = PK8(P1, 4, pq5, false), pq5 = PK8(P1, 6, pq5, true), pq5); \
    GAPA((void)0, P1[10], P1[11], P1[12], P1[13], pq6 = PK8(P1, 8, pq6, false), pq6 = PK8(P1, 10, pq6, true), pq6); \
    GAPA((void)0, P1[14], P1[15], 0.f, 0.f,       pq7 = PK8(P1, 12, pq7, false), pq7 = PK8(P1, 14, pq7, true), pq7); \
    DMAS; \
    CMASK(C0, C1, 0); \
    if constexpr (THRL >= 0) { float a = MX3(C0[0], C0[1], C1[0]), b = MX3(C0[2], C0[3], C1[1]); a = MX3(a, C1[2], C1[3]); \
      _Pragma("unroll") for (int r = 4; r < 16; r += 4) { a = MX3(a, C0[r], C0[r + 1]); b = MX3(b, C0[r + 2], C0[r + 3]); a = MX3(a, C1[r], C1[r + 1]); b = MX3(b, C1[r + 2], C1[r + 3]); } \
      float rm = __builtin_fmaxf(a, b); { auto rr = __builtin_amdgcn_permlane32_swap(__float_as_uint(rm), __float_as_uint(rm), false, false); rm = __builtin_fmaxf(__uint_as_float(rr[0]), __uint_as_float(rr[1])); } \
      resc = false; \
      if (__builtin_expect(__any(rm > (float)THRL), 0)) { const float dl = __builtin_fmaxf(rm, 0.f); mhat += dl; \
        _Pragma("unroll") for (int r = 0; r < 16; ++r) { C0[r] -= dl; C1[r] -= dl; } \
        _Pragma("unroll") for (int r = 0; r < 16; ++r) negm[r] = -mhat; asm volatile("" : "+v"(negm)); \
        const float f = __builtin_amdgcn_exp2f(-dl); if (hi == 0) wsf[r32] = f; resc = true; } } \
    SBAR(); \
    { const v8i_ pa_ = PQV(); \
      o[0] = MFMA8(pa_, VCAT(vq0, vq1), o[0]); SBAR(); EXG(C0, 0); EXG(C0, 4); KRD(GL, 0); EXG(C0, 8); KRD(GL, 1); EXG(C0, 12); \
      o[1] = MFMA8(pa_, VCAT(vq2, vq3), o[1]); SBAR(); KRD(GL, 2); EXG(C1, 0); KRD(GL, 3); EXG(C1, 4); \
      osum = MFMA8(pa_, vones, osum); SBAR(); EXG(C1, 8); EXG(C1, 12); } \
    } while (0)
  constexpr int NS = NT / 2;
  STEP(pB0, pB1, pA0, pA1, s1, s2, (void)0, true);
  WAIT_BAR(0); ROT();
  for (int T_ = 1; T_ + 2 < NS; ++T_) {
    STEP(pA0, pA1, pB0, pB1, s0 + 4096, s1 + 4096, DMA_K(T_ + 2, s0); DMA_V(T_ + 1, s2), true);
    STEP(pB0, pB1, pA0, pA1, s1, s2, (void)0, true);
    WAIT_BAR(0); ROT();
  }
  STEP(pA0, pA1, pB0, pB1, s0 + 4096, s1 + 4096, DMA_V(NS - 1, s2), true);
  STEP(pB0, pB1, pA0, pA1, s1, s2, (void)0, true);
  WAIT_BAR(0); ROT();
  STEP(pA0, pA1, pB0, pB1, s0 + 4096, s1 + 4096, (void)0, true);
  STEP(pB0, pB1, pA0, pA1, s1, s2, (void)0, false);
  {
    pq0 = PK8(pB0, 0, pq0, false); pq0 = PK8(pB0, 2, pq0, true); pq1 = PK8(pB0, 4, pq1, false); pq1 = PK8(pB0, 6, pq1, true); pq2 = PK8(pB0, 8, pq2, false); pq2 = PK8(pB0, 10, pq2, true); pq3 = PK8(pB0, 12, pq3, false); pq3 = PK8(pB0, 14, pq3, true);
    pq4 = PK8(pB1, 0, pq4, false); pq4 = PK8(pB1, 2, pq4, true); pq5 = PK8(pB1, 4, pq5, false); pq5 = PK8(pB1, 6, pq5, true); pq6 = PK8(pB1, 8, pq6, false); pq6 = PK8(pB1, 10, pq6, true); pq7 = PK8(pB1, 12, pq7, false); pq7 = PK8(pB1, 14, pq7, true);
    SBAR(); VQR(0, s1 + 4096); VQR(1, s1 + 4096); VQR(2, s1 + 4096); VQR(3, s1 + 4096);
    { const v8i_ pa_ = PQV(); o[0] = MFMA8(pa_, VCAT(vq0, vq1), o[0]); o[1] = MFMA8(pa_, VCAT(vq2, vq3), o[1]); osum = MFMA8(pa_, vones, osum); } }
  #undef PK8
  #undef PQV
  #undef VCAT
  #undef MFMA8
  #undef VQR
  #undef EXG
  #undef PIN
  #undef MX3
  #undef GAPA
  #undef GAPB
  #undef EX
  #undef KRD
  #undef KQR
  #undef KCAT
  #undef MFQK
  #undef STEP
  #undef ENDW
  float rli[16];
  #pragma unroll
  for (int r = 0; r < 16; ++r) rli[r] = __builtin_amdgcn_rcpf(osum[r]);
  bf16* Ow = O + (rowbase + q0 + wid * QBLK) * OP + h * D;
  { bf16* stg = (bf16*)(shm + LDS_OST) + wid * 2048;
    #pragma unroll
    for (int r = 0; r < 16; ++r) { const int orow = crow(r, hi);
      #pragma unroll
      for (int d0 = 0; d0 < 2; ++d0) stg[orow * 64 + d0 * 32 + r32] = __float2bfloat16(o[d0][r] * rli[r]); }
    asm volatile("s_waitcnt lgkmcnt(0)" ::: "memory");
    #pragma unroll
    for (int i = 0; i < 4; ++i) { const int row = i * 8 + (lane >> 3), ch = lane & 7; const u32x4 v = *(const u32x4*)(stg + row * 64 + ch * 8); ATTN_STORE16(Ow + (long)row * OP + ch * 8, v); } }
  asm volatile("s_waitcnt lgkmcnt(0)\n\ts_barrier" ::: "memory");
  #undef DMA_K
  #undef DMA_V
  #undef CMASK
  #undef START
  #undef RESC
  #undef ROT
}
constexpr int ATTN_LDS_BYTES = LDS_BYTES;
#undef SBAR
#undef WAIT_BAR
}

constexpr int NWAVES = 8, NTHREADS = NWAVES * 64;
constexpr size_t MiB = 1u << 20;
constexpr size_t WS_CTL = 0, CTL_ZERO_BYTES = 1 * MiB;
constexpr size_t WS_ROPE = 1 * MiB;
constexpr size_t WS_ROWSS = 5 * MiB;
constexpr size_t WS_TOK = 7 * MiB;
constexpr size_t WS_TMAP = 9 * MiB;
constexpr size_t WS_SMAP = 11 * MiB;
constexpr size_t WS_PB = 972 * MiB;
constexpr size_t WS_WIN = 25 * MiB;
constexpr size_t WS_WOUT = 32 * MiB;
constexpr size_t WS_WFGU = 36 * MiB;
constexpr size_t WS_WFD = 58 * MiB;
constexpr size_t WS_WPOOL = 69 * MiB;
constexpr size_t WS_WPG = 70 * MiB;
constexpr size_t WS_WPP = 78 * MiB;
constexpr size_t WS_HB = 80 * MiB;
constexpr size_t WS_WMGU = 144 * MiB;
constexpr size_t WS_HQ = 208 * MiB;
constexpr size_t WS_WMD = 256 * MiB;
constexpr size_t WS_R = 312 * MiB;
constexpr size_t WS_Q = WS_R, WS_K = WS_R + 32 * MiB, WS_V = WS_R + 40 * MiB, WS_G = WS_R + 48 * MiB, WS_MIX = WS_R + 80 * MiB, WS_FFNH = WS_R + 144 * MiB;
constexpr size_t WS_YPOOL = WS_R, WS_XPERM = WS_R, WS_HID = WS_R + 132 * MiB;
constexpr size_t WS_HB2 = 906 * MiB;
constexpr size_t WS_PPLE_E = WS_HB2;
constexpr size_t WS_PPLE_O = WS_HB;
constexpr size_t WS_ROWSS2 = 970 * MiB;
constexpr size_t WS_END = 1036 * MiB;
static_assert(WS_HID + (size_t)XROWS * EXPD * 2 <= WS_HB2 && WS_FFNH + (size_t)T * FFN * 2 <= WS_HB2 && (size_t)XROWS * DM * 2 <= 132 * MiB, "d_ws map");
constexpr int CW_CNT = 64;
constexpr int CW_BAR = 4096;
constexpr int CW_LCG = 24576;
constexpr int CW_WGB = 16384;

#define GAS __attribute__((address_space(1)))
#define LAS __attribute__((address_space(3)))
typedef unsigned short bf16;
typedef unsigned v4u __attribute__((ext_vector_type(4)));
typedef unsigned v2u __attribute__((ext_vector_type(2)));
typedef float f32x4 __attribute__((ext_vector_type(4)));
#define LDS_WAIT() asm volatile("s_waitcnt lgkmcnt(0)" ::: "memory")
__device__ __forceinline__ unsigned f2bf(float f) { unsigned u = __builtin_bit_cast(unsigned, f); return (u + 0x7fffu + ((u >> 16) & 1u)) >> 16; }
__device__ __forceinline__ unsigned pk2(float lo, float hi) { return f2bf(lo) | (f2bf(hi) << 16); }
__device__ __forceinline__ float bflo(unsigned w) { return __uint_as_float(w << 16); }
__device__ __forceinline__ float bfhi(unsigned w) { return __uint_as_float(w & 0xffff0000u); }

#define XB_TMO      128
#define XB_XCNT(j)  (256  + 64 * (j))
#define XB_XSUB(j)  (1280 + 64 * (j))
#define XB_XGEN(j)  (2304 + 64 * (j))
#define XB_TOP      3328
#define XB_TOPGEN   3392
#define XCD_BAR_WORDS 3456
#define XB_SPIN_CAP (1u << 18)
__device__ __forceinline__ unsigned xb_ld(unsigned* p)              { return __hip_atomic_load(p, __ATOMIC_RELAXED, __HIP_MEMORY_SCOPE_AGENT); }
__device__ __forceinline__ unsigned xb_add(unsigned* p, unsigned v) { return __hip_atomic_fetch_add(p, v, __ATOMIC_RELAXED, __HIP_MEMORY_SCOPE_AGENT); }
__device__ __forceinline__ unsigned xb_xcc_id() { return (unsigned)__builtin_amdgcn_s_getreg((3 << 11) | 20) & 0xFu; }
#define XB_SPIN(cond, bar) do { unsigned _sp = 0; while (cond) { __builtin_amdgcn_s_sleep(1); \
    if ((++_sp & 255u) == 0u) { if (xb_ld(&(bar)[XB_TMO])) break; if (_sp > XB_SPIN_CAP) { atomicAdd(&(bar)[XB_TMO], 1u); break; } } } } while (0)
struct XcdBarrier { unsigned* bar; unsigned x; volatile LAS unsigned* st; };
__device__ __forceinline__ XcdBarrier xcd_barrier_post(unsigned* bar, volatile LAS unsigned* st, bool leader) {
    XcdBarrier b; b.bar = bar; b.x = xb_xcc_id(); b.st = st;
    if (leader) (void)xb_add(&bar[XB_XCNT(b.x)], 1u);
    return b;
}
__device__ __forceinline__ void xcd_barrier_complete(unsigned* bar, unsigned x, unsigned& nloc, unsigned& nx) {
    const unsigned G = gridDim.x * gridDim.y * gridDim.z;
    unsigned sum, cnt, mine, sp = 0u;
    for (;;) {
        sum = 0u; cnt = 0u; mine = 0u;
#pragma unroll
        for (unsigned j = 0; j < 16; ++j) { const unsigned c = xb_ld(&bar[XB_XCNT(j)]); sum += c; cnt += (c > 0u) ? 1u : 0u; mine = (j == x) ? c : mine; }
        if (sum == G) break;
        __builtin_amdgcn_s_sleep(1);
        if ((++sp & 255u) == 0u) { if (xb_ld(&bar[XB_TMO])) break; if (sp > XB_SPIN_CAP) { atomicAdd(&bar[XB_TMO], 1u); break; } }
    }
    nloc = mine > 0u ? mine : 1u; nx = cnt > 0u ? cnt : 1u;
}
__device__ __forceinline__ void xcd_barrier(const XcdBarrier& b, bool leader) {
    asm volatile("s_waitcnt vmcnt(0)" ::: "memory");
    __syncthreads();
    if (leader) {
        unsigned* bar = b.bar;
        __builtin_amdgcn_s_waitcnt(0);
        unsigned nloc = b.st[0], nx = b.st[1];
        if (nloc == 0u) { xcd_barrier_complete(bar, b.x, nloc, nx); b.st[0] = nloc; b.st[1] = nx; }
        const unsigned old = xb_add(&bar[XB_XSUB(b.x)], 1u);
        const unsigned gen = old / nloc;
        if (old + 1u == (gen + 1u) * nloc) {
            __builtin_amdgcn_fence(__ATOMIC_RELEASE, "agent");
            asm volatile("s_waitcnt vmcnt(0)" ::: "memory");
            const unsigned og = xb_add(&bar[XB_TOP], 1u);
            const unsigned tg = og / nx;
            if (og + 1u == (tg + 1u) * nx) xb_add(&bar[XB_TOPGEN], 1u);
            else XB_SPIN(xb_ld(&bar[XB_TOPGEN]) == tg, bar);
            __builtin_amdgcn_fence(__ATOMIC_ACQUIRE, "agent");
            xb_add(&bar[XB_XGEN(b.x)], 1u);
            asm volatile("s_waitcnt vmcnt(0)" ::: "memory");
        } else {
            XB_SPIN(xb_ld(&bar[XB_XGEN(b.x)]) == gen, bar);
            __builtin_amdgcn_fence(__ATOMIC_ACQUIRE, "agent");
            asm volatile("s_waitcnt vmcnt(0)" ::: "memory");
        }
    }
    __syncthreads();
}

constexpr int RING_BYTES = 131072, LDSCTL_OFF = RING_BYTES, MISC_OFF = LDSCTL_OFF + 320, LDS_BYTES = 147456;

struct Params {
    const float* in[24]; float* out; unsigned char* ws; int ph_lo, ph_hi;
};
enum { I_X = 0, I_P, I_NORM_MIX, I_NORM_FFN, I_W_IN, I_Q_NORM, I_K_NORM, I_CONV_W, I_CONV_B, I_CLN_G, I_CLN_B, I_W_OUT, I_FFN_WG, I_FFN_WU, I_FFN_WD,
       I_POOL_W, I_POOL_SCALE, I_ROUTER_W, I_MOE_WG, I_MOE_WU, I_MOE_WD, I_PLE_NORM, I_PLE_GATE_W, I_PLE_PROJ };

typedef const float* cfp_t;
#define CAS __attribute__((address_space(4)))
struct Frame {
    LAS unsigned char* lds; int tid, lane, wave, vcu, G, gw, NGW, bx;
    unsigned char* ws; const cfp_t* in; float* out;
};
typedef const struct Params* kparams_t;
__device__ __forceinline__ kparams_t kparams() { auto p = __builtin_amdgcn_kernarg_segment_ptr(); asm volatile("" : "+s"(p)); return (kparams_t)(const void*)p; }
__device__ __forceinline__ float wave_sum(float v, int lane) {
#pragma unroll
    for (int o = 1; o < 64; o <<= 1) v += shx(v, o, lane);
    return v;
}

constexpr float W_F8_SCALE = 64.0f;
struct TrItem { f32x4 v[8]; float kg[8]; f32x4 ns; };
__device__ __forceinline__ void transpose_load(TrItem& t, const float* W, int ldw, int k0, int n0, const float* kgain, const float* nscale, int lane) {
    const int c4 = (lane & 7) * 4, kr = lane >> 3;
    t.ns = (f32x4){1.f, 1.f, 1.f, 1.f}; if (nscale) t.ns = *(const f32x4*)(nscale + n0 + c4);
#pragma unroll
    for (int i = 0; i < 8; ++i) { t.v[i] = *(const f32x4*)(W + (size_t)(k0 + 8 * i + kr) * ldw + n0 + c4); t.kg[i] = kgain ? kgain[k0 + 8 * i + kr] : 1.0f; }
}
template <bool F8> __device__ __forceinline__ void transpose_finish(const TrItem& t, int k0, bf16* WT, int ldt, int drow0, LAS float* scr, int lane) {
    const int c4 = (lane & 7) * 4, kr = lane >> 3;
#pragma unroll
    for (int i = 0; i < 8; ++i) { LAS float* d = scr + (8 * i + kr) * 33 + c4; const f32x4 x = t.v[i] * t.ns * t.kg[i]; d[0] = x[0]; d[1] = x[1]; d[2] = x[2]; d[3] = x[3]; }
    LDS_WAIT(); asm volatile("" ::: "memory");
    const int c = lane & 7;
#pragma unroll
    for (int j = 0; j < 4; ++j) { const int n = (lane >> 3) + 8 * j; const LAS float* s = scr + (8 * c) * 33 + n;
        if (F8) { unsigned a = 0u, b = 0u;
            a = (unsigned)__builtin_amdgcn_cvt_pk_fp8_f32(s[0 * 33] * W_F8_SCALE, s[1 * 33] * W_F8_SCALE, (int)a, false); a = (unsigned)__builtin_amdgcn_cvt_pk_fp8_f32(s[2 * 33] * W_F8_SCALE, s[3 * 33] * W_F8_SCALE, (int)a, true);
            b = (unsigned)__builtin_amdgcn_cvt_pk_fp8_f32(s[4 * 33] * W_F8_SCALE, s[5 * 33] * W_F8_SCALE, (int)b, false); b = (unsigned)__builtin_amdgcn_cvt_pk_fp8_f32(s[6 * 33] * W_F8_SCALE, s[7 * 33] * W_F8_SCALE, (int)b, true);
            v2u o; o.x = a; o.y = b; *(GAS v2u*)((unsigned char*)WT + (size_t)(drow0 + n) * ldt + k0 + 8 * c) = o; }
        else { v4u o; o.x = pk2(s[0 * 33], s[1 * 33]); o.y = pk2(s[2 * 33], s[3 * 33]); o.z = pk2(s[4 * 33], s[5 * 33]); o.w = pk2(s[6 * 33], s[7 * 33]);
            *(GAS v4u*)(WT + (size_t)(drow0 + n) * ldt + k0 + 8 * c) = o; } }
    LDS_WAIT(); asm volatile("" ::: "memory");
}
template <int MAP> __device__ __forceinline__ int dest_row(int n) {
    if (MAP == 1) {
        if (n < 512) { const int h = n >> 6, d = n & 63; return (h >> 2) * 256 + (d >> 5) * 128 + (h & 3) * 32 + (d & 31); }
        if (n < 768) { const int c = n - 512, hh = c >> 6  , d = c & 63; return 512 + (d >> 5) * 128 + hh * 32 + (d & 31); }
        if (n < 1280) { const int c = n - 768; return 768 + (c >> 7) * 256 + (c & 127); } const int c = n - 1280; return 768 + (c >> 7) * 256 + 128 + (c & 127); }
    if (MAP == 2) return (n >> 7) * 256 + (n & 127);
    if (MAP == 3) return (n >> 7) * 256 + 128 + (n & 127);
    return n;
}
#ifndef DENSE_F8_MASK
#define DENSE_F8_MASK 2
#endif
__device__ __forceinline__ constexpr bool dense_f8(int j) { return (DENSE_F8_MASK >> j) & 1; }
template <int MAP, bool F8 = false> __device__ __forceinline__ void conv_matrix(Frame& F, const float* W, int K, int N, const float* kgain, const float* nscale, bf16* WT, int ldt) {
    LAS float* scr = (LAS float*)(F.lds + F.wave * 16384);
    const int nblk = N / 32, nitems = (K / 64) * nblk;
    int it = F.gw; if (it >= nitems) return;
    TrItem ta; transpose_load(ta, W, N, 64 * (it / nblk), 32 * (it % nblk), kgain, nscale, F.lane);
#pragma nounroll
    for (;;) {
        const int nx = it + F.NGW; const bool more = nx < nitems; TrItem tb; if (more) transpose_load(tb, W, N, 64 * (nx / nblk), 32 * (nx % nblk), kgain, nscale, F.lane);
        asm volatile("" ::: "memory");
        transpose_finish<F8>(ta, 64 * (it / nblk), WT, ldt, dest_row<MAP>(32 * (it % nblk)), scr, F.lane); if (!more) break; it = nx; ta = tb;
    }
}
__device__ __forceinline__ void moe_convert(Frame& F, int j) {
    const float* g = F.in[I_NORM_FFN] + (2 * j + 1) * DM;
    for (int e = 0; e < NEXP; ++e) {
        const size_t we = (size_t)(j * NEXP + e) * DM * EXPD;
        bf16* gu = (bf16*)((unsigned char*)(F.ws + WS_WMGU) + (size_t)e * (2 * EXPD) * DM);
        conv_matrix<2, true>(F, F.in[I_MOE_WG] + we, DM, EXPD, g, nullptr, gu, DM);
        conv_matrix<3, true>(F, F.in[I_MOE_WU] + we, DM, EXPD, g, nullptr, gu, DM);
        conv_matrix<0, true>(F, F.in[I_MOE_WD] + we, EXPD, DM, nullptr, nullptr, (bf16*)((unsigned char*)(F.ws + WS_WMD) + (size_t)e * DM * EXPD), EXPD);
    }
}
__device__ __forceinline__ void light_cus(const Frame& F, int nwg, int& nl, int& li) {
    const int rounds = (nwg + F.G - 1) / F.G, nheavy = nwg - (rounds - 1) * F.G;
    if (nheavy >= F.G) { nl = F.G; li = F.bx; return; }
    nl = F.G - nheavy; li = F.bx - nheavy;
}
__device__ __forceinline__ void p_convert(Frame& F, int layer) {
    const float* p = F.in[I_P] + (size_t)layer * T * PLE; bf16* pb = (bf16*)(F.ws + WS_PB) + (size_t)layer * T * PLE;
    const size_t n8 = (size_t)T * PLE / 8;
    for (size_t i = (size_t)blockIdx.x * NTHREADS + F.tid; i < n8; i += (size_t)F.G * NTHREADS) {
        const f32x4 a = *(const f32x4*)(p + i * 8), b = *(const f32x4*)(p + i * 8 + 4);
        v4u o; o.x = pk2(a[0], a[1]); o.y = pk2(a[2], a[3]); o.z = pk2(b[0], b[1]); o.w = pk2(b[2], b[3]); *(v4u*)(pb + i * 8) = o; }
}
__device__ __forceinline__ void row_out(Frame& F, size_t row, const f32x4 (&v)[4], bf16* hbase, float* rsbase) {
    bf16* hb = hbase + row * DM; float* rowss = rsbase + row * 16; float ss = 0.f;
#pragma unroll
    for (int j = 0; j < 4; ++j) { ss += (v[j][0] * v[j][0] + v[j][1] * v[j][1]) + (v[j][2] * v[j][2] + v[j][3] * v[j][3]);
        v2u o; o.x = pk2(v[j][0], v[j][1]); o.y = pk2(v[j][2], v[j][3]); *(v2u*)(hb + 4 * F.lane + 256 * j) = o; }
    ss = wave_sum(ss, F.lane);
    if (F.lane < 16) rowss[F.lane] = F.lane == 0 ? ss : 0.f;
}

__device__ __forceinline__ void p0_prologue(Frame& F) {
    for (int j = 0; j < 2; ++j) {
        conv_matrix<1>(F, F.in[I_W_IN] + (size_t)j * DM * INPROJ, DM, INPROJ, F.in[I_NORM_MIX] + (2 * j) * DM, nullptr, (bf16*)(F.ws + WS_WIN) + (size_t)j * INPROJ * DM, DM);
        conv_matrix<0>(F, F.in[I_W_OUT] + (size_t)j * DM * DM, DM, DM, nullptr, nullptr, (bf16*)(F.ws + WS_WOUT) + (size_t)j * DM * DM, DM);
        if (dense_f8(j)) {
        conv_matrix<2, true>(F, F.in[I_FFN_WG] + (size_t)j * DM * FFN, DM, FFN, F.in[I_NORM_FFN] + (2 * j) * DM, nullptr, (bf16*)(F.ws + WS_WFGU) + (size_t)j * 2 * FFN * DM, DM);
        conv_matrix<3, true>(F, F.in[I_FFN_WU] + (size_t)j * DM * FFN, DM, FFN, F.in[I_NORM_FFN] + (2 * j) * DM, nullptr, (bf16*)(F.ws + WS_WFGU) + (size_t)j * 2 * FFN * DM, DM);
        conv_matrix<0, true>(F, F.in[I_FFN_WD] + (size_t)j * FFN * DM, FFN, DM, nullptr, nullptr, (bf16*)(F.ws + WS_WFD) + (size_t)j * DM * FFN, FFN);
        } else {
        conv_matrix<2>(F, F.in[I_FFN_WG] + (size_t)j * DM * FFN, DM, FFN, F.in[I_NORM_FFN] + (2 * j) * DM, nullptr, (bf16*)(F.ws + WS_WFGU) + (size_t)j * 2 * FFN * DM, DM);
        conv_matrix<3>(F, F.in[I_FFN_WU] + (size_t)j * DM * FFN, DM, FFN, F.in[I_NORM_FFN] + (2 * j) * DM, nullptr, (bf16*)(F.ws + WS_WFGU) + (size_t)j * 2 * FFN * DM, DM);
        conv_matrix<0>(F, F.in[I_FFN_WD] + (size_t)j * FFN * DM, FFN, DM, nullptr, nullptr, (bf16*)(F.ws + WS_WFD) + (size_t)j * DM * FFN, FFN);
        }
        for (int g = 0; g < 4; ++g)
            conv_matrix<0>(F, F.in[I_POOL_W] + (size_t)(j * 4 + g) * 65536, 256, 256, F.in[I_NORM_MIX] + (2 * j + 1) * DM + g * 256, F.in[I_POOL_SCALE] + j * DM + g * 256, (bf16*)(F.ws + WS_WPOOL) + (size_t)(j * 4 + g) * 65536, 256);
    }
    for (int i = 0; i < DEPTH; ++i) {
        conv_matrix<0>(F, F.in[I_PLE_GATE_W] + (size_t)i * DM * DM, DM, DM, F.in[I_PLE_NORM] + i * DM, nullptr, (bf16*)(F.ws + WS_WPG) + (size_t)i * DM * DM, DM);
        conv_matrix<0>(F, F.in[I_PLE_PROJ] + (size_t)i * PLE * DM, PLE, DM, nullptr, nullptr, (bf16*)(F.ws + WS_WPP) + (size_t)i * DM * PLE, PLE);
    }
    moe_convert(F, 0);
    for (int i = 0; i < DEPTH; ++i) p_convert(F, i);
    { float* ct = (float*)(F.ws + WS_ROPE); float* st = ct + SEQ * 32;
      for (int i = blockIdx.x * NTHREADS + F.tid; i < SEQ * 32; i += F.G * NTHREADS) { const int s = i >> 5, k = i & 31, jj = k & 15;
          const float inv = powf(10000.0f, -(float)jj / 16.0f); const float pos = (float)(k < 16 ? (s >> 6) : (s & 63)); const float ang = pos * inv;
          ct[i] = cosf(ang); st[i] = sinf(ang); } }
    for (int m = F.gw; m < T; m += F.NGW) { const float* xr = F.in[I_X] + (size_t)m * DM; f32x4 v[4];
#pragma unroll
        for (int j = 0; j < 4; ++j) v[j] = *(const f32x4*)(xr + 4 * F.lane + 256 * j);
        row_out(F, m, v, (bf16*)(F.ws + WS_HB), (float*)(F.ws + WS_ROWSS)); }
}

__device__ __forceinline__ float reduce16(float (&v)[16], int lane);
__device__ __forceinline__ void conv_phase(Frame& F, int j) {
    constexpr int TT = 32, RW = TT + 30;
    LAS unsigned short* xin = (LAS unsigned short*)F.lds;
    LAS float* red = (LAS float*)(F.lds + 65536);
    LAS float* stt = (LAS float*)(F.lds + 65536 + 8 * TT * 2 * 4);
    const bf16* Gb = (const bf16*)(F.ws + WS_G); bf16* mix = (bf16*)(F.ws + WS_MIX);
    const int c = F.tid;
    float w[CONVW];
#pragma unroll
    for (int k = 0; k < CONVW; ++k) w[k] = F.in[I_CONV_W][(size_t)(j * CONVW + k) * CONVC + c];
    const float cb = F.in[I_CONV_B][j * CONVC + c], lg = F.in[I_CLN_G][j * CONVC + c], lb = F.in[I_CLN_B][j * CONVC + c];
    const int nunits = T / TT;
    v4u vv[8];
#define CONV_LOAD(u_) do { const int b_ = (u_) / (SEQ / TT), t0_ = ((u_) % (SEQ / TT)) * TT; \
        _Pragma("unroll") for (int i = 0; i < 8; ++i) { const int ch = F.tid + i * NTHREADS, r = ch >> 6, cc = ch & 63, t = t0_ - 15 + r; \
            vv[i] = (v4u){0u, 0u, 0u, 0u}; if (ch < RW * 64 && t >= 0 && t < SEQ) vv[i] = *(const v4u*)(Gb + ((size_t)b_ * SEQ + t) * CONVC + cc * 8); } } while (0)
    int u = F.vcu; if (u < nunits) CONV_LOAD(u);
    for (; u < nunits; u += F.G) {
        const int b = u / (SEQ / TT), t0 = (u % (SEQ / TT)) * TT;
#pragma unroll
        for (int i = 0; i < 8; ++i) { const int ch = F.tid + i * NTHREADS; if (ch < RW * 64) *(LAS v4u*)(xin + (ch >> 6) * 512 + (ch & 63) * 8) = vv[i]; }
        __syncthreads();
        float x[RW];
#pragma unroll
        for (int r = 0; r < RW; ++r) x[r] = __uint_as_float((unsigned)xin[r * 512 + c] << 16);
        asm volatile("s_waitcnt lgkmcnt(0)" ::: "memory");
        { const int un = u + F.G; if (un < nunits) CONV_LOAD(un); }
        float uo[TT];
#pragma unroll
        for (int tt = 0; tt < TT; ++tt) { float a = cb;
#pragma unroll
            for (int k = 0; k < CONVW; ++k) a += w[k] * x[tt + k];
            uo[tt] = a; }
#pragma unroll
        for (int h = 0; h < 2; ++h) { float v1[16], v2[16];
#pragma unroll
            for (int i = 0; i < 16; ++i) { v1[i] = uo[16 * h + i]; v2[i] = uo[16 * h + i] * uo[16 * h + i]; }
            const float s1 = reduce16(v1, F.lane), s2 = reduce16(v2, F.lane);
            if ((F.lane & 3) == 0) { LAS float* rp = red + (F.wave * TT + 16 * h + ((F.lane >> 2) & 15)) * 2; rp[0] = s1; rp[1] = s2; } }
        __syncthreads();
        if (F.tid < TT) { float s1 = 0.f, s2 = 0.f;
#pragma unroll
            for (int wv = 0; wv < 8; ++wv) { s1 += red[(wv * TT + F.tid) * 2]; s2 += red[(wv * TT + F.tid) * 2 + 1]; }
            const float mu = s1 * (1.0f / CONVC); float var = s2 * (1.0f / CONVC) - mu * mu; var = var > 0.f ? var : 0.f;
            stt[F.tid * 2] = mu; stt[F.tid * 2 + 1] = 1.0f / sqrtf(var + EPS); }
        __syncthreads();
#pragma unroll
        for (int tt = 0; tt < TT; ++tt) { const float y = (uo[tt] - stt[tt * 2]) * stt[tt * 2 + 1] * lg + lb; const float o = y * pg8::fsigmoid(y);
            mix[((size_t)b * SEQ + t0 + tt) * DM + QDIM + c] = (bf16)f2bf(o); }
        __syncthreads();
    }
#undef CONV_LOAD
}

__device__ __forceinline__ void load8(const bf16* p, float sc, float (&x)[8]) {
    const v4u w = *(const v4u*)p;
    x[0] = sc * bflo(w.x); x[1] = sc * bfhi(w.x); x[2] = sc * bflo(w.y); x[3] = sc * bfhi(w.y); x[4] = sc * bflo(w.z); x[5] = sc * bfhi(w.z); x[6] = sc * bflo(w.w); x[7] = sc * bfhi(w.w);
}
__device__ __forceinline__ void pool_stencil(Frame& F, const bf16* hb, const float* rowss) {
    constexpr int TT = 128, R0 = 8, RW = TT + 16, TP = TT / 4;
    LAS float* srow = (LAS float*)F.lds;
    bf16* yp = (bf16*)(F.ws + WS_YPOOL);
    const int c = (F.tid & 127) * 8, g = c >> 8, wdw = 2 << g, left = wdw >> 1, right = wdw - 1 - left, part = F.tid >> 7;
    const int nunits = T / TT;
    for (int u = F.vcu; u < nunits; u += F.G) {
        const int b = u / (SEQ / TT), t0 = (u % (SEQ / TT)) * TT;
        const bf16* xb = hb + (size_t)b * SEQ * DM + c; bf16* yb = yp + (size_t)b * SEQ * DM + c;
        if (F.tid < RW) { const int t = t0 - R0 + F.tid; float sv = 0.f;
            if (t >= 0 && t < SEQ) { const float* rs = rowss + ((size_t)b * SEQ + t) * 16; float ss = 0.f;
#pragma unroll
                for (int q = 0; q < 16; ++q) ss += rs[q];
                sv = 1.0f / sqrtf(ss * (1.0f / DM) + EPS); }
            srow[F.tid] = sv; }
        __syncthreads();
        const int tb = t0 + part * TP;
        float S[8];
#pragma unroll
        for (int e = 0; e < 8; ++e) S[e] = 0.f;
#pragma unroll
        for (int q = -8; q <= 7; ++q) {
            const int r = tb + q; const bool in = (q >= -left) && (q <= right); const int rc = r < 0 ? 0 : (r > SEQ - 1 ? SEQ - 1 : r);
            const float sc = in ? srow[r - t0 + R0] : 0.f; float x[8]; load8(xb + (size_t)rc * DM, sc, x);
#pragma unroll
            for (int e = 0; e < 8; ++e) S[e] += x[e]; }
#pragma unroll 4
        for (int i = 0; i < TP; ++i) { const int t = tb + i;
            int lo = t - left, hi = t + right; lo = lo < 0 ? 0 : lo; hi = hi > SEQ - 1 ? SEQ - 1 : hi; const float ic = 1.0f / (float)(hi - lo + 1);
            float xc[8]; load8(xb + (size_t)t * DM, srow[t - t0 + R0], xc);
            v4u o; o.x = pk2(S[0] * ic - xc[0], S[1] * ic - xc[1]); o.y = pk2(S[2] * ic - xc[2], S[3] * ic - xc[3]); o.z = pk2(S[4] * ic - xc[4], S[5] * ic - xc[5]); o.w = pk2(S[6] * ic - xc[6], S[7] * ic - xc[7]);
            *(v4u*)(yb + (size_t)t * DM) = o;
            const int rn = t + 1 + right, ro = t - left;
            const int rnc = rn > SEQ - 1 ? SEQ - 1 : rn, roc = ro < 0 ? 0 : ro;
            float xn[8], xo[8]; load8(xb + (size_t)rnc * DM, srow[rn - t0 + R0], xn); load8(xb + (size_t)roc * DM, srow[ro - t0 + R0], xo);
#pragma unroll
            for (int e = 0; e < 8; ++e) S[e] += xn[e] - xo[e]; }
        __syncthreads();
    }
}

__device__ __forceinline__ float reduce16(float (&v)[16], int lane) {
#pragma unroll
    for (int i = 0; i < 8; ++i) { const bool up = lane & 32; const float snd = up ? v[i] : v[i + 8], kp = up ? v[i + 8] : v[i]; v[i] = kp + shx(snd, 32, lane); }
#pragma unroll
    for (int i = 0; i < 4; ++i) { const bool up = lane & 16; const float snd = up ? v[i] : v[i + 4], kp = up ? v[i + 4] : v[i]; v[i] = kp + shx(snd, 16, lane); }
#pragma unroll
    for (int i = 0; i < 2; ++i) { const bool up = lane & 8; const float snd = up ? v[i] : v[i + 2], kp = up ? v[i + 2] : v[i]; v[i] = kp + shx(snd, 8, lane); }
    { const bool up = lane & 4; const float snd = up ? v[0] : v[1], kp = up ? v[1] : v[0]; v[0] = kp + shx(snd, 4, lane); }
    v[0] += shx(v[0], 2, lane); v[0] += shx(v[0], 1, lane);
    return v[0];
}
__device__ __forceinline__ float rdlane(float v, int l) { return __int_as_float(__builtin_amdgcn_readlane(__float_as_int(v), l)); }
constexpr int RT_WTOT = 0, RT_ENT = 256, RT_ARR = 32768, RT_MISC = RT_ARR + 16384;
__device__ __forceinline__ void route_phase1(Frame& F, int j, const bf16* hb) {
    const float* g = F.in[I_NORM_FFN] + (2 * j + 1) * DM; const float* rw = F.in[I_ROUTER_W] + (size_t)j * DM * NEXP;
    LAS unsigned* wtot = (LAS unsigned*)(F.lds + RT_WTOT); LAS unsigned* ent = (LAS unsigned*)(F.lds + RT_ENT);
    unsigned cw[NEXP];
#pragma unroll
    for (int e = 0; e < NEXP; ++e) cw[e] = 0u;
    int nk = 0;
    f32x4 rwa[16], rwb[16];
#pragma unroll
    for (int q = 0; q < 4; ++q) { const int k0 = 4 * F.lane + 256 * q; const f32x4 gv = *(const f32x4*)(g + k0);
#pragma unroll
        for (int i = 0; i < 4; ++i) { rwa[4 * q + i] = *(const f32x4*)(rw + (size_t)(k0 + i) * NEXP) * gv[i]; rwb[4 * q + i] = *(const f32x4*)(rw + (size_t)(k0 + i) * NEXP + 4) * gv[i]; } }
    for (int m = F.gw; m < T; m += F.NGW, ++nk) {
        float v[16];
#pragma unroll
        for (int e = 0; e < 16; ++e) v[e] = 0.f;
#pragma unroll
        for (int q = 0; q < 4; ++q) { const int k0 = 4 * F.lane + 256 * q; const v2u hw = *(const v2u*)(hb + (size_t)m * DM + k0); const f32x4 hv = (f32x4){bflo(hw.x), bfhi(hw.x), bflo(hw.y), bfhi(hw.y)};
#pragma unroll
            for (int i = 0; i < 4; ++i) { const float x = hv[i]; v[8] += x * x; const f32x4 r0 = rwa[4 * q + i], r1 = rwb[4 * q + i];
                v[0] += x * r0[0]; v[1] += x * r0[1]; v[2] += x * r0[2]; v[3] += x * r0[3]; v[4] += x * r1[0]; v[5] += x * r1[1]; v[6] += x * r1[2]; v[7] += x * r1[3]; } }
        const float red = reduce16(v, F.lane);
        const float sv = 1.0f / sqrtf(rdlane(red, 32) * (1.0f / DM) + EPS);
        float lg[NEXP];
#pragma unroll
        for (int e = 0; e < NEXP; ++e) lg[e] = rdlane(red, 4 * e) * sv;
        int i0 = 0; float v0 = lg[0];
#pragma unroll
        for (int e = 1; e < NEXP; ++e) if (lg[e] > v0) { v0 = lg[e]; i0 = e; }
        int i1 = -1; float v1 = -INFINITY;
#pragma unroll
        for (int e = 0; e < NEXP; ++e) if (e != i0 && lg[e] > v1) { v1 = lg[e]; i1 = e; }
        const float p0 = 1.0f / (1.0f + expf(v1 - v0)), p1 = 1.0f - p0;
        unsigned lp0 = 0u, lp1 = 0u;
#pragma unroll
        for (int e = 0; e < NEXP; ++e) { if (e == i0) { lp0 = cw[e]; cw[e] += 1u; } if (e == i1) { lp1 = cw[e]; cw[e] += 1u; } }
        if (F.lane == 0 && nk < 64) { LAS unsigned* en = ent + (F.wave * 64 + nk) * 8; en[0] = (unsigned)m; en[1] = (unsigned)i0 | ((unsigned)i1 << 8); en[2] = lp0 | (lp1 << 16); en[3] = __float_as_uint(sv); en[4] = __float_as_uint(p0); en[5] = __float_as_uint(p1); }
    }
    { unsigned mine = 0u;
#pragma unroll
      for (int e = 0; e < NEXP; ++e) mine = (F.lane == e) ? cw[e] : mine;
      if (F.lane < NEXP) wtot[F.wave * NEXP + F.lane] = mine; }
    __syncthreads();
    if (F.tid < NEXP) { unsigned t = 0u;
#pragma unroll
        for (int w = 0; w < NWAVES; ++w) t += wtot[w * NEXP + F.tid];
        ((unsigned*)(F.ws + WS_CTL) + CW_LCG)[F.vcu * NEXP + F.tid] = t; }
}
__device__ __forceinline__ void route_phase2(Frame& F, int j) {
    unsigned* cnt = (unsigned*)(F.ws + WS_CTL) + CW_CNT + 64 * j; unsigned* tok = (unsigned*)(F.ws + WS_TOK); const unsigned* lcg = (const unsigned*)(F.ws + WS_CTL) + CW_LCG;
    unsigned* tmap = (unsigned*)(F.ws + WS_TMAP); float* smap = (float*)(F.ws + WS_SMAP);
    LAS unsigned* wtot = (LAS unsigned*)(F.lds + RT_WTOT); LAS unsigned* ent = (LAS unsigned*)(F.lds + RT_ENT); LAS unsigned* arr = (LAS unsigned*)(F.lds + RT_ARR);
    LAS unsigned* lbase = (LAS unsigned*)(F.lds + RT_MISC); LAS unsigned* woff = lbase + 8;
    for (int v = F.tid; v < F.G; v += NTHREADS) { const v4u a = *(const v4u*)(lcg + v * NEXP), b = *(const v4u*)(lcg + v * NEXP + 4); *(LAS v4u*)(arr + v * NEXP) = a; *(LAS v4u*)(arr + v * NEXP + 4) = b; }
    __syncthreads();
    { LAS unsigned* part = woff + 64;
      const int e = F.tid & 7, ch = F.tid >> 3, per = (F.G + 63) / 64; unsigned base = 0u, tot = 0u;
      for (int v = ch * per; v < (ch + 1) * per && v < F.G; ++v) { const unsigned c = arr[v * NEXP + e]; base += (v < F.vcu) ? c : 0u; tot += c; }
      part[(ch * NEXP + e) * 2] = base; part[(ch * NEXP + e) * 2 + 1] = tot;
      __syncthreads();
      if (F.tid < NEXP) { unsigned b2 = 0u, t2 = 0u;
          for (int c2 = 0; c2 < 64; ++c2) { b2 += part[(c2 * NEXP + F.tid) * 2]; t2 += part[(c2 * NEXP + F.tid) * 2 + 1]; }
          lbase[F.tid] = b2; lbase[1100 + F.tid] = t2; ((unsigned*)(F.ws + WS_CTL) + CW_WGB)[F.vcu * NEXP + F.tid] = b2; if (F.vcu == 0) cnt[F.tid] = t2; } }
    if (F.tid < NWAVES * NEXP) { const int w = F.tid >> 3, e = F.tid & 7; unsigned o = 0u;
        for (int q = 0; q < w; ++q) o += wtot[q * NEXP + e];
        woff[F.tid] = o; }
    __syncthreads();
    if (F.vcu < NEXP && F.tid < 256) { const unsigned tot = lbase[1100 + F.vcu], pos = tot + (unsigned)F.tid;
        if (pos < ((tot + 255u) & ~255u)) { tmap[(size_t)F.vcu * T + pos] = 0u; smap[(size_t)F.vcu * T + pos] = 0.f; } }
    const int nk = F.gw < T ? (T - 1 - F.gw) / F.NGW + 1 : 0;
    if (F.lane < nk && F.lane < 64) { const LAS unsigned* en = ent + (F.wave * 64 + F.lane) * 8; const unsigned m = en[0], ee = en[1], lp = en[2]; const float sv = __uint_as_float(en[3]);
        const unsigned e0 = ee & 255u, e1 = ee >> 8, w0 = woff[F.wave * NEXP + e0] + (lp & 0xffffu), w1 = woff[F.wave * NEXP + e1] + (lp >> 16), q0 = lbase[e0] + w0, q1 = lbase[e1] + w1;
        tmap[(size_t)e0 * T + q0] = m; smap[(size_t)e0 * T + q0] = sv; tmap[(size_t)e1 * T + q1] = m; smap[(size_t)e1 * T + q1] = sv;
        v4u a; a.x = ee; a.y = w0 | (w1 << 16); a.z = en[4]; a.w = en[5]; *(v4u*)(tok + (size_t)m * 4) = a; }
    __syncthreads();
}
__device__ __forceinline__ void tile_offsets(const unsigned* cnt, int (&toff)[NEXP + 1]) {
    toff[0] = 0;
#pragma unroll
    for (int e = 0; e < NEXP; ++e) toff[e + 1] = toff[e] + (int)((__hip_atomic_load(cnt + e, __ATOMIC_RELAXED, __HIP_MEMORY_SCOPE_AGENT) + 255u) >> 8);
}
__device__ __forceinline__ void combine_phase(Frame& F, int j, bf16* hbo, float* rso) {
    const unsigned* tok = (const unsigned*)(F.ws + WS_TOK); const bf16* yp = (const bf16*)(F.ws + WS_XPERM);
    LAS unsigned* ltoff = (LAS unsigned*)F.lds;
    if (F.tid == 0) { int toff[NEXP + 1]; tile_offsets((const unsigned*)(F.ws + WS_CTL) + CW_CNT + 64 * j, toff);
#pragma unroll
        for (int e = 0; e < NEXP; ++e) ltoff[e] = (unsigned)toff[e] * 256u; }
    __syncthreads();
    for (int m = F.gw; m < T; m += F.NGW) {
        const v4u a = *(const v4u*)(tok + (size_t)m * 4); const float p0 = __uint_as_float(a.z), p1 = __uint_as_float(a.w);
        const unsigned e0 = a.x & 255u, e1 = a.x >> 8; const unsigned* wgb = (const unsigned*)(F.ws + WS_CTL) + CW_WGB + ((m % F.NGW) >> 3) * NEXP;
        const size_t s0 = ltoff[e0] + wgb[e0] + (a.y & 0xffffu), s1 = ltoff[e1] + wgb[e1] + (a.y >> 16);
        f32x4 v[4];
#pragma unroll
        for (int q = 0; q < 4; ++q) { const int k0 = 4 * F.lane + 256 * q; const v2u hw = *(const v2u*)(hbo + (size_t)m * DM + k0); v[q] = (f32x4){bflo(hw.x), bfhi(hw.x), bflo(hw.y), bfhi(hw.y)};
            const v2u y0 = *(const v2u*)(yp + s0 * DM + k0), y1 = *(const v2u*)(yp + s1 * DM + k0);
            v[q][0] += p0 * bflo(y0.x) + p1 * bflo(y1.x); v[q][1] += p0 * bfhi(y0.x) + p1 * bfhi(y1.x); v[q][2] += p0 * bflo(y0.y) + p1 * bflo(y1.y); v[q][3] += p0 * bfhi(y0.y) + p1 * bfhi(y1.y); }
        row_out(F, m, v, hbo, rso);
    }
    __syncthreads();
}

struct DenseSched {
    pg8::GridOrder o; const char* A; const char* B; size_t astep, bstep;
    __device__ __forceinline__ bool next(int i, pg8::Unit& u) const { int pm, pn; if (!o.tile(i, pm, pn)) return false; u.pm = pm; u.pn = pn; u.e = 0; u.a = A + (size_t)pm * astep; u.b = B + (size_t)pn * bstep; return true; }
};
struct PoolSched {
    pg8::GridOrder o; const char* A; const char* B;
    __device__ __forceinline__ bool next(int i, pg8::Unit& u) const { int pm, pn; if (!o.tile(i, pm, pn)) return false; u.pm = pm; u.pn = pn; u.e = pn; u.a = A + ((size_t)pm * 256 * DM + pn * 256) * 2; u.b = B + (size_t)pn * 65536 * 2; return true; }
};
struct MoeSched {
    pg8::GridOrder o; const char* A; const char* B; size_t astep, wstride  , bstep; const LAS int* ltoff  ; const unsigned* tmap; const float* smap;
    __device__ __forceinline__ int counts(const unsigned* cnt, LAS int* tab) {
        int t = 0;
#pragma unroll
        for (int e = 0; e < NEXP; ++e) { tab[e] = t; t += (int)((__hip_atomic_load(cnt + e, __ATOMIC_RELAXED, __HIP_MEMORY_SCOPE_AGENT) + 255u) >> 8); }
        tab[NEXP] = t; ltoff = tab; __syncthreads(); return __builtin_amdgcn_readfirstlane(t); }
    __device__ __forceinline__ bool next(int i, pg8::Unit& u) const { int pm, pn; if (!o.tile(i, pm, pn)) return false; int e = 0, t0 = 0;
#pragma unroll
        for (int q = 1; q < NEXP; ++q) { const int tq = ltoff[q]; const bool ge = pm >= tq; e += ge ? 1 : 0; t0 = ge ? tq : t0; }
        e = __builtin_amdgcn_readfirstlane(e); t0 = __builtin_amdgcn_readfirstlane(t0);
        const int pos0 = (pm - t0) * 256;
        u.pm = pm; u.pn = pn; u.e = e; u.a = A + (size_t)pm * astep; u.b = B + (size_t)e * wstride + (size_t)pn * bstep;
        u.map = tmap + (size_t)e * T + pos0; u.srow = smap + (size_t)e * T + pos0; u.nvalid = 256; return true; }
};

constexpr int PH_PER_PAIR = 14, N_PHASES = 1 + 2 * PH_PER_PAIR;
__device__ __forceinline__ Frame mk_frame(LAS unsigned char* lds, const int wave) {
    kparams_t kp = kparams(); Frame F;
    { int w_ = wave; asm volatile("" : "+s"(w_)); F.wave = w_; }
    F.lds = lds; F.lane = opaque_lane(); F.tid = F.wave * 64 + F.lane;
    { int g_ = gridDim.x, b_ = blockIdx.x; asm volatile("" : "+s"(g_), "+s"(b_)); F.G = g_; F.bx = b_; }
    { const int bx = F.bx; F.vcu = (F.G % 8 == 0) ? (bx % 8) * (F.G / 8) + bx / 8 : bx; }
    F.gw = F.vcu * NWAVES + F.wave; F.NGW = F.G * NWAVES; F.ws = kp->ws; F.in = kp->in; F.out = kp->out;
    return F;
}
__device__ __forceinline__ void grid_bar(LAS unsigned char* lds, const int wave) {
    kparams_t kp = kparams(); XcdBarrier b; b.bar = (unsigned*)(kp->ws + WS_CTL) + CW_BAR; b.x = xb_xcc_id(); b.st = (volatile LAS unsigned*)(lds + MISC_OFF) + 8;
    xcd_barrier(b, wave == 0 && opaque_lane() == 0);
}
#ifndef PHMASK
#define PHMASK 0xFFFFFFFFu
#endif
#ifndef PROBE_REP
#define PROBE_REP 0u
#endif
#define PHASE(id, ...) do { kparams_t kp_ = kparams(); const int ph = ((id) == 0) ? 0 : PH_PER_PAIR * j + (id); const int lo = kp_->ph_lo, hi = kp_->ph_hi; \
    if (ph >= lo && ph < hi) { if constexpr ((PHMASK >> (id)) & 1u) { Frame F = mk_frame(ldsb, WV); unsigned char* const ws = F.ws; LAS unsigned char* const ring = F.lds; \
        bf16* const HB0 = (bf16*)(ws + WS_HB); bf16* const HB1 = (bf16*)(ws + WS_HB2); float* const RS0 = (float*)(ws + WS_ROWSS); float* const RS1 = (float*)(ws + WS_ROWSS2); \
        (void)HB0; (void)HB1; (void)RS0; (void)RS1; (void)ring; int nrep_ = ((((PROBE_REP) >> (id)) & 1u) ? 2 : 1); if constexpr (((PROBE_REP) >> (id)) & 1u) asm volatile("" : "+s"(nrep_)); _Pragma("nounroll") for (int rep_ = 0; rep_ < nrep_; ++rep_) { __VA_ARGS__; } } if (ph + 1 < hi) grid_bar(ldsb, WV); } } while (0)
#define DENSE_SCHED(S, nN_, Aptr, Bptr, lda_, ldb_) DenseSched S; S.o.init(T / 256, (nN_), F.G, F.bx); S.A = (const char*)(Aptr); S.B = (const char*)(Bptr); S.astep = (size_t)256 * (lda_) * 2; S.bstep = (size_t)256 * (ldb_) * 2
#define PLE_PROJ_GEMM(L_, dst, nwg_) do { int nl_, li_; light_cus(F, (nwg_), nl_, li_); if (li_ >= 0) { \
        DenseSched Sp; Sp.o.init(T / 256, DM / 256, nl_, li_); Sp.A = (const char*)(ws + WS_PB + (size_t)(L_) * T * PLE * 2); Sp.B = (const char*)((ws + WS_WPP) + (size_t)(L_) * DM * PLE * 2); Sp.astep = (size_t)256 * PLE * 2; Sp.bstep = (size_t)256 * PLE * 2; \
        pg8::EpiStore Ep{(bf16*)(dst), DM}; pg8::gemm_phase(ring, pg8::Gemm{PLE, PLE, PLE}, Sp, Ep, F.wave); } } while (0)
template <int j> __device__ __forceinline__ void layer_pair(LAS unsigned char* const ldsb, const int WV, unsigned char* const lds_raw) {
    {
        constexpr int L = 2 * j;
        PHASE(1, { DENSE_SCHED(S, INPROJ / 256, HB0, (ws + WS_WIN) + (size_t)j * INPROJ * DM * 2, DM, DM);
                   pg8::EpiInProj E{(bf16*)(ws + WS_Q), (bf16*)(ws + WS_K), (bf16*)(ws + WS_V), (bf16*)(ws + WS_G), RS0, (const float*)(ws + WS_ROPE), F.in[I_Q_NORM] + j * HD, F.in[I_K_NORM] + j * HD};
                   pg8::gemm_phase(ring, pg8::Gemm{DM, DM, DM}, S, E, F.wave);
                   PLE_PROJ_GEMM(L, ws + WS_PPLE_E, (T / 256) * (INPROJ / 256)); });
        PHASE(2, { const bool mem_first = false;
                   for (int u = F.vcu; u < 1024; u += F.G) { const int i = u >> 8, v = u & 255, grp = v >> 6, qb = v & 63;
                       attn_body::attn_unit<-1>(grp >> 1, (grp & 1) * 4 + i, qb, (const unsigned char*)(ws + WS_Q), (const unsigned char*)(ws + WS_K), (const unsigned char*)(ws + WS_V), (attn_body::bf16*)(ws + WS_MIX), (char*)lds_raw, F.wave); }
                   if (!mem_first) { conv_phase(F, j); if (j == 1) moe_convert(F, 1); } });
        PHASE(3, { { DENSE_SCHED(S, DM / 256, ws + WS_MIX, (ws + WS_WOUT) + (size_t)j * DM * DM * 2, DM, DM);
                     pg8::EpiResid E{HB0, RS1, dense_f8(j) ? (unsigned char*)(ws + WS_HQ) : nullptr};
                     pg8::gemm_phase(ring, pg8::Gemm{DM, DM, DM}, S, E, F.wave); }
                   });
        PHASE(4, { constexpr bool F8 = dense_f8(j); constexpr int KU = F8 ? DM / 2 : DM;
                   DENSE_SCHED(S, 2 * FFN / 256, F8 ? ws + WS_HQ : (unsigned char*)HB0, (ws + WS_WFGU) + (size_t)j * 2 * FFN * DM * 2, KU, KU);
                   pg8::EpiSwiGLU<false, F8> E{(bf16*)(ws + WS_FFNH), FFN, RS1};
                   pg8::gemm_phase<pg8::EpiSwiGLU<false, F8>, DenseSched, false, F8>(ring, pg8::Gemm{KU, KU, KU, 0x7F7F7F7F, F8 ? 0x79797979   : 0x7F7F7F7F}, S, E, F.wave); });
        PHASE(5, { constexpr bool F8 = dense_f8(j); constexpr int KD = F8 ? FFN / 2 : FFN;
                   DENSE_SCHED(S, DM / 256, ws + WS_FFNH, (ws + WS_WFD) + (size_t)j * DM * FFN * 2, KD, KD);
                   pg8::EpiResid E{HB0, RS0, nullptr};
                   pg8::gemm_phase<pg8::EpiResid, DenseSched, false, F8>(ring, pg8::Gemm{KD, KD, KD, F8 ? 0x7D7D7D7D   : 0x7F7F7F7F, F8 ? 0x79797979   : 0x7F7F7F7F}, S, E, F.wave); });
        PHASE(6, { DENSE_SCHED(S, DM / 256, HB0, (ws + WS_WPG) + (size_t)L * DM * DM * 2, DM, DM);
                   pg8::EpiPle<false> E{HB0, HB1, nullptr, RS1, RS0, (const bf16*)(ws + WS_PPLE_E)};
                   pg8::gemm_phase(ring, pg8::Gemm{DM, DM, DM}, S, E, F.wave); });
    }
    {
        constexpr int L = 2 * j + 1;
        PHASE(7, pool_stencil(F, HB1, RS1));
        PHASE(8, { PoolSched S; S.o.init(T / 256, 4, F.G, F.bx); S.A = (const char*)(ws + WS_YPOOL); S.B = (const char*)(ws + WS_WPOOL) + (size_t)j * 4 * 65536 * 2;
                   pg8::EpiResid E{HB1, RS0, (unsigned char*)(ws + WS_HQ)};
                   pg8::gemm_phase(ring, pg8::Gemm{DM, 256, 256}, S, E, F.wave); });
        PHASE(9, route_phase1(F, j, HB1));
        PHASE(10, route_phase2(F, j));
        PHASE(11, { MoeSched S; const int nrt = S.counts((const unsigned*)(ws + WS_CTL) + CW_CNT + 64 * j, (LAS int*)(F.lds + MISC_OFF + 64)); S.o.init(nrt, 2 * EXPD / 256, F.G, F.bx); S.A = (const char*)(ws + WS_HQ); S.B = (const char*)(ws + WS_WMGU);
                    S.astep = 0; S.wstride = (size_t)2 * EXPD * DM; S.bstep = (size_t)256 * DM; S.tmap = (const unsigned*)(ws + WS_TMAP); S.smap = (const float*)(ws + WS_SMAP);
                    pg8::EpiSwiGLU<true, true> E{(bf16*)(ws + WS_HID), EXPD, nullptr};
                    pg8::gemm_phase<pg8::EpiSwiGLU<true, true>, MoeSched, true, true>(ring, pg8::Gemm{DM / 2, DM / 2, DM / 2, 0x7F7F7F7F, 0x79797979  }, S, E, F.wave); });
        PHASE(12, { MoeSched S; const int nrt = S.counts((const unsigned*)(ws + WS_CTL) + CW_CNT + 64 * j, (LAS int*)(F.lds + MISC_OFF + 64)); S.o.init(nrt, DM / 256, F.G, F.bx); S.A = (const char*)(ws + WS_HID); S.B = (const char*)(ws + WS_WMD);
                    S.astep = (size_t)256 * EXPD; S.wstride = (size_t)DM * EXPD; S.bstep = (size_t)256 * EXPD; S.tmap = (const unsigned*)(ws + WS_TMAP); S.smap = (const float*)(ws + WS_SMAP);
                    pg8::EpiStore E{(bf16*)(ws + WS_XPERM), DM};
                    pg8::gemm_phase<pg8::EpiStore, MoeSched, false, true>(ring, pg8::Gemm{EXPD / 2, EXPD / 2, EXPD / 2, 0x7D7D7D7D  , 0x79797979  }, S, E, F.wave);
                    PLE_PROJ_GEMM(L, ws + WS_PPLE_O, nrt * (DM / 256)); });
        PHASE(13, combine_phase(F, j, HB1, RS1));
        PHASE(14, { DENSE_SCHED(S, DM / 256, HB1, (ws + WS_WPG) + (size_t)L * DM * DM * 2, DM, DM);
                    pg8::EpiPle<(j == 1)> E{HB1, HB0, F.out, RS0, RS1, (const bf16*)(ws + WS_PPLE_O)};
                    pg8::gemm_phase(ring, pg8::Gemm{DM, DM, DM}, S, E, F.wave); });
    }
}
__global__ void __launch_bounds__(NTHREADS, 2) fwd_kernel(Params P) {
    extern __shared__ __attribute__((aligned(16))) unsigned char lds_raw[];
    LAS unsigned char* const ldsb = (LAS unsigned char*)lds_raw;
    const int WV = __builtin_amdgcn_readfirstlane(threadIdx.x >> 6);
    for (int u = threadIdx.x; u < (LDS_BYTES - LDSCTL_OFF) / 4; u += NTHREADS) ((LAS unsigned*)(ldsb + LDSCTL_OFF))[u] = 0u;
    __syncthreads();
    { kparams_t kp = kparams(); if (kp->ph_hi - kp->ph_lo > 1) (void)xcd_barrier_post((unsigned*)(kp->ws + WS_CTL) + CW_BAR, (volatile LAS unsigned*)(ldsb + MISC_OFF) + 8, threadIdx.x == 0); }

    { const int j = 0; PHASE(0, p0_prologue(F)); }

    layer_pair<0>(ldsb, WV, lds_raw);
    layer_pair<1>(ldsb, WV, lds_raw);
}
#undef PHASE


extern "C" void kernel_launch(void* const* d_in, const int* in_sizes, int n_in, void* d_out, int out_size, void* d_ws, size_t ws_size, hipStream_t stream) {
    static int grid = 0;
    if (grid == 0) {
        if (n_in != 24 || in_sizes[0] != T * DM || out_size != T * DM || ws_size < WS_END) { fprintf(stderr, "kernel_launch: unexpected shapes (n_in %d, in0 %d, out %d, ws %zu < %zu); nothing launched\n", n_in, n_in > 0 ? in_sizes[0] : -1, out_size, ws_size, (size_t)WS_END); grid = -1; return; }
        int dev = 0, cus = 0, per_cu = 0;
        if (hipGetDevice(&dev) != hipSuccess || hipDeviceGetAttribute(&cus, hipDeviceAttributeMultiprocessorCount, dev) != hipSuccess) { grid = -1; return; }
        if (hipFuncSetAttribute((const void*)fwd_kernel, hipFuncAttributeMaxDynamicSharedMemorySize, LDS_BYTES) != hipSuccess) { fprintf(stderr, "kernel_launch: hipFuncSetAttribute failed\n"); grid = -1; return; }
        if (hipOccupancyMaxActiveBlocksPerMultiprocessor(&per_cu, (const void*)fwd_kernel, NTHREADS, LDS_BYTES) != hipSuccess || per_cu < 1) fprintf(stderr, "kernel_launch: occupancy query says %d\n", per_cu);
        (void)hipGetLastError();
        grid = cus;
    }
    if (grid < 0) return;
    (void)hipMemsetAsync((char*)d_ws + WS_CTL, 0, CTL_ZERO_BYTES, stream);
    Params p{};
    for (int i = 0; i < 24; ++i) p.in[i] = (const float*)d_in[i];
    p.out = (float*)d_out; p.ws = (unsigned char*)d_ws;
#if MK_ONE_LAUNCH
    p.ph_lo = 0; p.ph_hi = N_PHASES;
    hipLaunchKernelGGL(fwd_kernel, dim3(grid), dim3(NTHREADS), LDS_BYTES, stream, p);
#else
    for (int k = 0; k < N_PHASES; ++k) { p.ph_lo = k; p.ph_hi = k + 1; hipLaunchKernelGGL(fwd_kernel, dim3(grid), dim3(NTHREADS), LDS_BYTES, stream, p); }
#endif
    const hipError_t le = hipPeekAtLastError();
    if (le != hipSuccess) fprintf(stderr, "kernel_launch: launch failed: %s\n", hipGetErrorName(le));
}
```

```cpp
#include <hip/hip_runtime.h>
#include <hip/hip_bf16.h>
#include <cstdio>
#include <cstdint>
#include <cmath>

#ifndef MK_ONE_LAUNCH
#define MK_ONE_LAUNCH 1
#endif

constexpr int BATCH = 2, SEQ = 16384, DM = 1024, T = BATCH * SEQ, DEPTH = 4;
constexpr int NH = 8, KVH = 2, HD = 64, QDIM = 512, KVDIM = 128, CONVC = 512, CONVW = 31, INPROJ = 1792;
constexpr int FFN = 2816, NEXP = 8, EXPD = 3584, PLE = 256;
constexpr float EPS = 1e-6f;
constexpr int XROWS = 67584;

__device__ __forceinline__ int opaque_lane() { int l; asm volatile("v_mbcnt_lo_u32_b32 %0, -1, 0\n\tv_mbcnt_hi_u32_b32 %0, -1, %0" : "=v"(l)); return l; }
__device__ __forceinline__ float shx(float v, int mask, int lane) { return __int_as_float(__builtin_amdgcn_ds_bpermute((lane ^ mask) << 2, __float_as_int(v))); }

namespace pg8 {
#define PG8_LAS __attribute__((address_space(3)))
typedef unsigned short bf16_t;
typedef short bf16x8 __attribute__((ext_vector_type(8)));
typedef float f32x4 __attribute__((ext_vector_type(4)));
typedef float f32x2 __attribute__((ext_vector_type(2)));
typedef unsigned u32x4 __attribute__((ext_vector_type(4)));
typedef int v4i_t __attribute__((ext_vector_type(4)));
typedef int v8i_t __attribute__((ext_vector_type(8)));
typedef unsigned u32x2 __attribute__((ext_vector_type(2)));
constexpr int BM = 256, BK = 64, HALF = 128, HTB = HALF * BK * 2, STAGE_BYTES = 8 * HTB, NXCD = 8, WGM = 8;

__host__ __device__ __forceinline__ int lds_byte(int r, int c) { const int st = (r >> 4) * 2 + (c >> 5), rr = r & 15, cc = c & 31, ob = rr * 64 + cc * 2; return st * 1024 + (ob ^ (((ob >> 9) & 1) << 5)); }
__host__ __device__ __forceinline__ void stage_rc(int b, int& R, int& C) { const int st = b / 1024, sb = b % 1024, swz = sb ^ (((sb >> 9) & 1) << 5); R = (st >> 1) * 16 + swz / 64; C = (st & 1) * 32 + (swz % 64) / 2; }
__host__ __device__ __forceinline__ int perm32(int rho) { const int n = rho >> 4, i = rho & 15; return 8 * (i >> 2) + 4 * n + (i & 3); }

struct Unit { const char* a; const char* b; int pm, pn, e; const unsigned* map; const float* srow; int nvalid; const PG8_LAS float* sl  ; };
struct Gemm { int lda, ldb, K; int sa = 0x7F7F7F7F, sb = 0x7F7F7F7F; };

struct GridOrder {
    int nM, nN, nwg, G, c;
    __device__ __forceinline__ void init(int nM_, int nN_, int G_, int c_) { nM = nM_; nN = nN_; nwg = nM * nN; G = G_; c = c_; }
    __device__ __forceinline__ bool tile(int i, int& pm, int& pn) const {
        const long L = (long)i * G + c; if (L >= nwg) return false;
        int wgid = (int)L; { const int q = nwg / NXCD, r = nwg % NXCD, xcd = wgid % NXCD, off = wgid / NXCD; wgid = (xcd < r ? xcd * (q + 1) : r * (q + 1) + (xcd - r) * q) + off; }
        const int nig = WGM * nN, gid = wgid / nig, fm = gid * WGM, gsz = (nM - fm) < WGM ? (nM - fm) : WGM;
        pm = fm + ((wgid % nig) % gsz); pn = (wgid % nig) / gsz; return true;
    }
};

__device__ __forceinline__ unsigned cvt_pk_bf16(float lo, float hi) { unsigned r; asm volatile("v_cvt_pk_bf16_f32 %0, %1, %2" : "=v"(r) : "v"(lo), "v"(hi)); return r; }
__device__ __forceinline__ float fsigmoid(float x) { return __builtin_amdgcn_rcpf(1.0f + __builtin_amdgcn_exp2f(-1.4426950408889634f * x)); }
__device__ __forceinline__ float bf_lo(unsigned w) { return __uint_as_float(w << 16); }
__device__ __forceinline__ float bf_hi(unsigned w) { return __uint_as_float(w & 0xffff0000u); }

typedef f32x4 Acc[2][2][4][2];

__device__ __forceinline__ void row_scales(const float* rowss, int row0, int fq, int lane, float (&s)[2][4]) {
#pragma unroll
    for (int ai = 0; ai < 2; ++ai)
#pragma unroll
        for (int m = 0; m < 4; ++m) {
            const f32x4 v = *(const f32x4*)(rowss + (size_t)(row0 + ai * HALF + m * 16) * 16 + 4 * fq);
            float t = (v[0] + v[1]) + (v[2] + v[3]); t += shx(t, 16, lane); t += shx(t, 32, lane);
            s[ai][m] = __builtin_amdgcn_rsqf(t * (1.0f / 1024.0f) + EPS);
        }
}
__device__ __forceinline__ u32x4 pack8(const f32x4 v0, const f32x4 v1) { u32x4 w; w.x = cvt_pk_bf16(v0[0], v0[1]); w.y = cvt_pk_bf16(v0[2], v0[3]); w.z = cvt_pk_bf16(v1[0], v1[1]); w.w = cvt_pk_bf16(v1[2], v1[3]); return w; }

__device__ __forceinline__ u32x2 pack8_fp8(const f32x4 v0, const f32x4 v1, float sc) {
    unsigned a = 0u, b = 0u;
    a = (unsigned)__builtin_amdgcn_cvt_pk_fp8_f32(v0[0] * sc, v0[1] * sc, (int)a, false); a = (unsigned)__builtin_amdgcn_cvt_pk_fp8_f32(v0[2] * sc, v0[3] * sc, (int)a, true);
    b = (unsigned)__builtin_amdgcn_cvt_pk_fp8_f32(v1[0] * sc, v1[1] * sc, (int)b, false); b = (unsigned)__builtin_amdgcn_cvt_pk_fp8_f32(v1[2] * sc, v1[3] * sc, (int)b, true);
    u32x2 r; r.x = a; r.y = b; return r;
}

constexpr float ATT_C2 = 1.4426950408889634f;
struct EpiInProj {
    static constexpr bool PERM = true;
    bf16_t *Q, *Kb, *Vb, *Gb; const float* rowss; const float* rope  ; const float* gq; const float* gk;
    __device__ __forceinline__ void operator()(const Acc& acc, const Unit& u, int wave) const {
        const int lane = opaque_lane(), wr = wave >> 2, wc = wave & 3, fr = lane & 15, fq = lane >> 4; (void)lane;
        const int row0 = u.pm * BM + wr * 64 + fr, cw = wc * 32 + 8 * fq;
        float s[2][4]; row_scales(rowss, row0, fq, lane, s);
        if (u.pn < 2 || (u.pn == 2 && wc < 2)) {
            const bool isq = u.pn < 2; const float* gain = isq ? gq : gk; const float osc = isq ? ATT_C2 : 1.0f;
            unsigned char* dst = isq ? (unsigned char*)Q + (4 * u.pn + wc) * HD : (unsigned char*)Kb + wc * HD; const int ld = isq ? QDIM : KVDIM;
#pragma unroll
            for (int ai = 0; ai < 2; ++ai)
#pragma unroll
                for (int m = 0; m < 4; ++m) { const size_t row = row0 + ai * HALF + m * 16; const float sc = s[ai][m];
                    float ss = 0.f;
#pragma unroll
                    for (int bj = 0; bj < 2; ++bj)
#pragma unroll
                        for (int n = 0; n < 2; ++n) { const f32x4 x = acc[ai][bj][m][n] * sc; ss += (x[0] * x[0] + x[1] * x[1]) + (x[2] * x[2] + x[3] * x[3]); }
                    ss += shx(ss, 16, lane); ss += shx(ss, 32, lane);
                    const float rs = sc * __builtin_amdgcn_rsqf(ss * (1.0f / HD) + EPS);
                    const float* cp = rope + (size_t)(row & (SEQ - 1)) * 32 + 8 * fq; f32x4 o1[2], o2[2];
#pragma unroll
                    for (int n = 0; n < 2; ++n) { const f32x4 c = *(const f32x4*)(cp + 4 * n), sn = *(const f32x4*)(cp + SEQ * 32 + 4 * n);
                        const f32x4 y1 = acc[ai][0][m][n] * rs * *(const f32x4*)(gain + 8 * fq + 4 * n), y2 = acc[ai][1][m][n] * rs * *(const f32x4*)(gain + 32 + 8 * fq + 4 * n);
                        o1[n] = (y1 * c - y2 * sn) * osc; o2[n] = (y2 * c + y1 * sn) * osc; }
                    *(u32x2*)(dst + row * ld + 8 * fq) = pack8_fp8(o1[0], o1[1], 1.0f); *(u32x2*)(dst + row * ld + 32 + 8 * fq) = pack8_fp8(o2[0], o2[1], 1.0f);
                    asm volatile("" ::: "memory"); }
        } else if (u.pn == 2) {
#pragma unroll
            for (int ai = 0; ai < 2; ++ai)
#pragma unroll
                for (int m = 0; m < 4; ++m) { const int row = row0 + ai * HALF + m * 16; const float sc = s[ai][m];
                    const int sq = row & (SEQ - 1), kv = sq & 63, w = kv & 31, pos = 32 * ((w >> 2) & 1) + (w & 3) + 4 * (w >> 3) + 16 * (kv >> 5);
                    unsigned char* dst = (unsigned char*)Vb + ((size_t)((row / SEQ) * KVH + (wc - 2)) * (SEQ / 64) + (sq >> 6)) * 4096 + pos + (8 * fq) * 64;
#pragma unroll
                    for (int bj = 0; bj < 2; ++bj)
#pragma unroll
                        for (int n = 0; n < 2; ++n) { const f32x4 x = acc[ai][bj][m][n] * sc;
                            const unsigned a = (unsigned)__builtin_amdgcn_cvt_pk_fp8_f32(x[0], x[1], 0, false), b2 = (unsigned)__builtin_amdgcn_cvt_pk_fp8_f32(x[2], x[3], 0, false);
                            unsigned char* d4 = dst + (bj * 32 + n * 4) * 64;
                            d4[0] = (unsigned char)(a & 255u); d4[64] = (unsigned char)((a >> 8) & 255u); d4[128] = (unsigned char)(b2 & 255u); d4[192] = (unsigned char)((b2 >> 8) & 255u); } }
        } else {
#pragma unroll
            for (int ai = 0; ai < 2; ++ai)
#pragma unroll
                for (int m = 0; m < 4; ++m) { const size_t row = row0 + ai * HALF + m * 16; const float sc = s[ai][m]; f32x4 g[2];
#pragma unroll
                    for (int n = 0; n < 2; ++n)
#pragma unroll
                        for (int e = 0; e < 4; ++e) g[n][e] = acc[ai][0][m][n][e] * (sc * __builtin_amdgcn_rcpf(1.0f + __builtin_amdgcn_exp2f(acc[ai][1][m][n][e] * (-1.4426950408889634f * sc))));
                    *(u32x4*)(Gb + row * CONVC + (u.pn - 3) * HALF + cw) = pack8(g[0], g[1]); }
        }
    }
};

constexpr float HID_F8_SCALE = 4.0f;
__device__ __forceinline__ void unpack8(const u32x4 w, f32x4& v0, f32x4& v1) { v0[0] = bf_lo(w.x); v0[1] = bf_hi(w.x); v0[2] = bf_lo(w.y); v0[3] = bf_hi(w.y); v1[0] = bf_lo(w.z); v1[1] = bf_hi(w.z); v1[2] = bf_lo(w.w); v1[3] = bf_hi(w.w); }
__device__ __forceinline__ float ssq8(const f32x4 v0, const f32x4 v1) { return ((v0[0] * v0[0] + v0[1] * v0[1]) + (v0[2] * v0[2] + v0[3] * v0[3])) + ((v1[0] * v1[0] + v1[1] * v1[1]) + (v1[2] * v1[2] + v1[3] * v1[3])); }
struct EpiResid {
    static constexpr bool PERM = true;
    bf16_t* hb; float* rowss; unsigned char* hq;
    __device__ __forceinline__ void operator()(const Acc& acc, const Unit& u, int wave) const {
        const int lane = opaque_lane(), wr = wave >> 2, wc = wave & 3, fr = lane & 15, fq = lane >> 4; (void)lane;
        const int row0 = u.pm * BM + wr * 64 + fr, cw = wc * 32 + 8 * fq;
#pragma unroll
        for (int ai = 0; ai < 2; ++ai)
#pragma unroll
            for (int m = 0; m < 4; ++m) { const size_t row = row0 + ai * HALF + m * 16; float ssq = 0.f;
#pragma unroll
                for (int bj = 0; bj < 2; ++bj) { const size_t off = row * DM + u.pn * 256 + bj * HALF + cw;
                    f32x4 r0, r1; unpack8(*(const u32x4*)(hb + off), r0, r1);
                    const f32x4 v0 = r0 + acc[ai][bj][m][0], v1 = r1 + acc[ai][bj][m][1];
                    *(u32x4*)(hb + off) = pack8(v0, v1); ssq += ssq8(v0, v1);
                    if (hq) *(u32x2*)(hq + off) = pack8_fp8(v0, v1, 1.0f); }
                ssq += shx(ssq, 16, lane); ssq += shx(ssq, 32, lane);
                if (fq == 0) rowss[row * 16 + u.pn * 4 + wc] = ssq;
                asm volatile("" ::: "memory"); }
    }
};
template <bool MOE, bool F8 = false> struct EpiSwiGLU {
    static constexpr bool PERM = true;
    bf16_t* H; int ldh; const float* sc;
    __device__ __forceinline__ void operator()(const Acc& acc, const Unit& u, int wave) const {
        const int lane = opaque_lane(), wr = wave >> 2, wc = wave & 3, fr = lane & 15, fq = lane >> 4; (void)lane;
        const int row0 = u.pm * BM + wr * 64 + fr, cw = wc * 32 + 8 * fq;
        float s[2][4];
        if (MOE) {
#pragma unroll
            for (int ai = 0; ai < 2; ++ai)
#pragma unroll
                for (int m = 0; m < 4; ++m) s[ai][m] = u.sl[wr * 64 + fr + ai * HALF + m * 16];
        } else row_scales(sc, row0, fq, lane, s);
#pragma unroll
        for (int ai = 0; ai < 2; ++ai)
#pragma unroll
            for (int m = 0; m < 4; ++m) { const size_t row = row0 + ai * HALF + m * 16; const float sv = s[ai][m], nsv = -1.4426950408889634f * sv;
                const float c = __builtin_amdgcn_rcpf((F8 ? HID_F8_SCALE : 1.0f) * sv * sv); f32x4 g[2];
#pragma unroll
                for (int n = 0; n < 2; ++n)
                    { const f32x4 pr = acc[ai][0][m][n] * acc[ai][1][m][n]; const f32x4 tt = acc[ai][0][m][n] * nsv; f32x4 ex, rc;
#pragma unroll
                      for (int e = 0; e < 4; ++e) ex[e] = __builtin_amdgcn_exp2f(tt[e]);
                      const f32x4 den = ex * c + c;
#pragma unroll
                      for (int e = 0; e < 4; ++e) rc[e] = __builtin_amdgcn_rcpf(den[e]);
                      g[n] = pr * rc; }
                if (F8) *(u32x2*)((unsigned char*)H + row * ldh + u.pn * HALF + cw) = pack8_fp8(g[0], g[1], 1.0f);
                else *(u32x4*)(H + row * ldh + u.pn * HALF + cw) = pack8(g[0], g[1]); }
    }
};
struct EpiStore {
    static constexpr bool PERM = true;
    bf16_t* O; int ldc;
    __device__ __forceinline__ void operator()(const Acc& acc, const Unit& u, int wave) const {
        const int lane = opaque_lane(), wr = wave >> 2, wc = wave & 3, fr = lane & 15, fq = lane >> 4; (void)lane;
        const int row0 = u.pm * BM + wr * 64 + fr, cw = wc * 32 + 8 * fq;
#pragma unroll
        for (int ai = 0; ai < 2; ++ai)
#pragma unroll
            for (int m = 0; m < 4; ++m) { const size_t row = row0 + ai * HALF + m * 16;
#pragma unroll
                for (int bj = 0; bj < 2; ++bj) *(u32x4*)(O + row * ldc + u.pn * 256 + bj * HALF + cw) = pack8(acc[ai][bj][m][0], acc[ai][bj][m][1]); }
    }
};
template <bool FINAL> struct EpiPle {
    static constexpr bool PERM = true;
    const bf16_t* hin; bf16_t* hout; float* fout; float* rowss_out; const float* rowss_in; const bf16_t* pple;
    __device__ __forceinline__ void operator()(const Acc& acc, const Unit& u, int wave) const {
        const int lane = opaque_lane(), wr = wave >> 2, wc = wave & 3, fr = lane & 15, fq = lane >> 4; (void)lane;
        const int row0 = u.pm * BM + wr * 64 + fr, cw = wc * 32 + 8 * fq;
        float s[2][4]; row_scales(rowss_in, row0, fq, lane, s);
#pragma unroll
        for (int ai = 0; ai < 2; ++ai)
#pragma unroll
            for (int m = 0; m < 4; ++m) { const size_t row = row0 + ai * HALF + m * 16; const float sv = s[ai][m]; float ssq = 0.f;
#pragma unroll
                for (int bj = 0; bj < 2; ++bj) { const size_t off = row * DM + u.pn * 256 + bj * HALF + cw;
                    f32x4 r0, r1, p0, p1; unpack8(*(const u32x4*)(hin + off), r0, r1); unpack8(*(const u32x4*)(pple + off), p0, p1);
                    const float nsv = -1.4426950408889634f * sv; const f32x4 a0 = acc[ai][bj][m][0] * nsv, a1 = acc[ai][bj][m][1] * nsv;
                    f32x4 v0, v1;
#pragma unroll
                    for (int e = 0; e < 4; ++e) { v0[e] = r0[e] + __builtin_amdgcn_rcpf(1.0f + __builtin_amdgcn_exp2f(a0[e])) * p0[e]; v1[e] = r1[e] + __builtin_amdgcn_rcpf(1.0f + __builtin_amdgcn_exp2f(a1[e])) * p1[e]; }
                    if (FINAL) { *(f32x4*)(fout + off) = v0; *(f32x4*)(fout + off + 4) = v1; }
                    else { *(u32x4*)(hout + off) = pack8(v0, v1); ssq += ssq8(v0, v1); } }
                if (!FINAL) { ssq += shx(ssq, 16, lane); ssq += shx(ssq, 32, lane);
                    if (fq == 0) rowss_out[row * 16 + u.pn * 4 + wc] = ssq; }
                asm volatile("" ::: "memory"); }
    }
};

template <class Epi, class Sched, bool GATHER = false, bool FP8 = false>
__device__ __forceinline__ void gemm_phase(PG8_LAS unsigned char* lds, const Gemm g, const Sched& S, const Epi& E, const int wid) {
    const int lane = opaque_lane(), tid = wid * 64 + lane, wr = wid >> 2, wc = wid & 3, fr = lane & 15, fq = lane >> 4;
    const int K = g.K, nt = K / BK;
    unsigned voffA[2], voffB[2]; int gR[2]; unsigned gC[2];
#pragma unroll
    for (int i = 0; i < 2; ++i) { int R, C; stage_rc(tid * 16 + i * 8192, R, C); const int Rb = Epi::PERM ? ((R & ~31) + perm32(R & 31)) : R;
        voffA[i] = (unsigned)(R * g.lda + C) * 2u; voffB[i] = (unsigned)(Rb * g.ldb + C) * 2u; gR[i] = R; gC[i] = (unsigned)C * 2u; }
    unsigned vC0[2], vC1[2], vN0[2], vN1[2];
    constexpr int IDX_OFF = 132096;
#define PG8_IDMA(u_, buf) do { if (wid == 0) __builtin_amdgcn_global_load_lds((const unsigned*)((const char*)(u_).map + lane * 16), (PG8_LAS unsigned*)(lds + IDX_OFF + (buf) * 1024), 16, 0, 0); } while (0)
#define PG8_SDMA(u_, buf) do { if (wid == 1) __builtin_amdgcn_global_load_lds((const unsigned*)((const char*)(u_).srow + lane * 16), (PG8_LAS unsigned*)(lds + IDX_OFF + 2048 + (buf) * 1024), 16, 0, 0); } while (0)
#define PG8_GIDX(u_, buf, v0, v1) do { asm volatile("" ::: "memory"); const PG8_LAS unsigned* ib_ = (const PG8_LAS unsigned*)(lds + IDX_OFF + (buf) * 1024); \
        _Pragma("unroll") for (int _i = 0; _i < 2; ++_i) {   \
        v0[_i] = ib_[gR[_i]] * (unsigned)(g.lda * 2) + gC[_i]; v1[_i] = ib_[gR[_i] + HALF] * (unsigned)(g.lda * 2) + gC[_i]; } } while (0)
#define PG8_STA(bufoff, gbase, h, nx) do { if constexpr (GATHER) { unsigned v_[2]; v_[0] = (nx) ? vN##h[0] : vC##h[0]; v_[1] = (nx) ? vN##h[1] : vC##h[1]; PG8_STAGE(bufoff, gbase, v_); } \
        else { PG8_STAGE(bufoff, (gbase) + (h) * hstepA, voffA); } } while (0)
    const size_t kstep = (size_t)(BK * 2);
    const size_t hstepA = (size_t)HALF * g.lda * 2, hstepB = (size_t)HALF * g.ldb * 2;
    const unsigned ldsw = (unsigned)wid * 1024u;
    const int aoff = lds_byte(wr * 64 + fr, fq * 8), boff = lds_byte(wc * 32 + fr, fq * 8);
#define PG8_SA(b, h) (((b) * 2 + (h)) * HTB)
#define PG8_SB(b, h) ((4 + (b) * 2 + (h)) * HTB)
#define PG8_STAGE(bufoff, gbase, voff) do { _Pragma("unroll") for (int _i = 0; _i < 2; ++_i) \
        __builtin_amdgcn_global_load_lds((const unsigned*)((const char*)(gbase) + (voff)[_i]), (PG8_LAS unsigned*)(lds + (bufoff) + ldsw + _i * 8192), 16, 0, 0); } while (0)
#define PG8_LDA(dst, b, h) do { _Pragma("unroll") for (int m = 0; m < 4; ++m) _Pragma("unroll") for (int k = 0; k < 2; ++k) dst[m][k] = *(const PG8_LAS bf16x8*)(lds + PG8_SA(b, h) + aoff + m * 2048 + k * 1024); } while (0)
#define PG8_LDB(dst, b, h) do { _Pragma("unroll") for (int n = 0; n < 2; ++n) _Pragma("unroll") for (int k = 0; k < 2; ++k) dst[n][k] = *(const PG8_LAS bf16x8*)(lds + PG8_SB(b, h) + boff + n * 2048 + k * 1024); } while (0)
#define PG8_CAT8(lo, hi) __builtin_shufflevector(__builtin_bit_cast(v4i_t, lo), __builtin_bit_cast(v4i_t, hi), 0, 1, 2, 3, 4, 5, 6, 7)
#define PG8_MMA(ai, bj, At, Bt) do { __builtin_amdgcn_s_setprio(1); _Pragma("unroll") for (int m = 0; m < 4; ++m) _Pragma("unroll") for (int n = 0; n < 2; ++n) { \
        if constexpr (FP8) { const v8i_t b8_ = PG8_CAT8(Bt[n][0], Bt[n][1]), a8_ = PG8_CAT8(At[m][0], At[m][1]);   \
            asm volatile("v_mfma_scale_f32_16x16x128_f8f6f4 %0, %1, %2, %0, %3, %4 op_sel_hi:[0,0,0]" : "+v"(acc[ai][bj][m][n]) : "v"(b8_), "v"(a8_), "v"(sbv), "v"(sav)); } \
        else { _Pragma("unroll") for (int k = 0; k < 2; ++k) acc[ai][bj][m][n] = __builtin_amdgcn_mfma_f32_16x16x32_bf16(Bt[n][k], At[m][k], acc[ai][bj][m][n], 0, 0, 0); } } \
        __builtin_amdgcn_s_setprio(0); } while (0)
#define PG8_WAIT_V(n) asm volatile("s_waitcnt vmcnt(" #n ")" ::: "memory")
#define PG8_WAIT_L(n) asm volatile("s_waitcnt lgkmcnt(" #n ")" ::: "memory")
#define PG8_BAR __builtin_amdgcn_s_barrier()
#define PG8_SCHED __builtin_amdgcn_sched_barrier(0)
    int sav = g.sa, sbv = g.sb; if constexpr (FP8) { asm volatile("" : "+v"(sav), "+v"(sbv)); }
    Unit cur, nxt; int ui = 0;
    if (!S.next(0, cur)) return;
    Acc acc;
#pragma unroll
    for (int a = 0; a < 2; ++a)
#pragma unroll
        for (int b = 0; b < 2; ++b)
#pragma unroll
            for (int m = 0; m < 4; ++m)
#pragma unroll
                for (int n = 0; n < 2; ++n) acc[a][b][m][n] = (f32x4){0.f, 0.f, 0.f, 0.f};
    bf16x8 At[4][2], B0[2][2], B1[2][2];
    const char* cA = cur.a; const char* cB = cur.b;
    if constexpr (GATHER) { PG8_IDMA(cur, 0); PG8_SDMA(cur, 0); PG8_WAIT_V(0); PG8_BAR; PG8_GIDX(cur, 0, vC0, vC1); cur.sl = (const PG8_LAS float*)(lds + IDX_OFF + 2048); }
    PG8_STAGE(PG8_SB(0, 0), cB, voffB); PG8_STAGE(PG8_SB(0, 1), cB + hstepB, voffB); PG8_STA(PG8_SA(0, 0), cA, 0, false); PG8_STA(PG8_SA(0, 1), cA, 1, false);
    if (wr == 1) PG8_BAR;
    PG8_WAIT_V(2); PG8_BAR;
    PG8_STAGE(PG8_SB(1, 0), cB + kstep, voffB); PG8_STA(PG8_SA(1, 0), cA + kstep, 0, false); PG8_STAGE(PG8_SB(1, 1), cB + hstepB + kstep, voffB);
    PG8_WAIT_V(6); PG8_BAR;
    for (;;) {
        const bool has_next = S.next(ui + 1, nxt);
        const char* nA = has_next ? nxt.a : cA; const char* nB = has_next ? nxt.b : cB;
        if constexpr (GATHER) { if (has_next) { PG8_IDMA(nxt, (ui + 1) & 1); } vN0[0] = vC0[0]; vN0[1] = vC0[1]; vN1[0] = vC1[0]; vN1[1] = vC1[1]; }
        for (int t = 0; t < nt; t += 2) {
            const bool last = (t == nt - 2);
            const char* a1 = cA + (size_t)(t + 1) * kstep;
            const char* a2 = last ? nA : cA + (size_t)(t + 2) * kstep; const char* b2 = last ? nB : cB + (size_t)(t + 2) * kstep;
            const char* a3 = a2 + kstep; const char* b3 = b2 + kstep;
            asm volatile("" : "+s"(a1), "+s"(a2), "+s"(a3), "+s"(b2), "+s"(b3));
            if constexpr (GATHER) { if (last && has_next) { PG8_GIDX(nxt, (ui + 1) & 1, vN0, vN1); } }
            PG8_LDB(B0, 0, 0); PG8_LDB(B1, 0, 1); PG8_SCHED; PG8_LDA(At, 0, 0); PG8_STA(PG8_SA(1, 1), a1, 1, false);
            PG8_WAIT_V(8); PG8_WAIT_L(0); PG8_BAR;
            if constexpr (GATHER) { if (t == 0 && has_next) { PG8_SDMA(nxt, (ui + 1) & 1); } }
            PG8_MMA(0, 0, At, B0); PG8_MMA(0, 1, At, B1); PG8_BAR; PG8_SCHED;
            PG8_LDA(At, 0, 1); PG8_STAGE(PG8_SB(0, 0), b2, voffB); PG8_STAGE(PG8_SB(0, 1), b2 + hstepB, voffB); PG8_STA(PG8_SA(0, 0), a2, 0, last);
            PG8_WAIT_V(8); PG8_WAIT_L(0); PG8_BAR; PG8_MMA(1, 0, At, B0); PG8_MMA(1, 1, At, B1); PG8_BAR; PG8_SCHED;
            PG8_LDB(B0, 1, 0); PG8_LDB(B1, 1, 1); PG8_SCHED; PG8_LDA(At, 1, 0); PG8_STA(PG8_SA(0, 1), a2, 1, last);
            PG8_WAIT_V(8); PG8_WAIT_L(0); PG8_BAR; PG8_MMA(0, 0, At, B0); PG8_MMA(0, 1, At, B1); PG8_BAR; PG8_SCHED;
            PG8_LDA(At, 1, 1); PG8_STAGE(PG8_SB(1, 0), b3, voffB); PG8_STAGE(PG8_SB(1, 1), b3 + hstepB, voffB); PG8_STA(PG8_SA(1, 0), a3, 0, last);
            PG8_WAIT_V(8); PG8_WAIT_L(0); PG8_BAR; PG8_MMA(1, 0, At, B0); PG8_MMA(1, 1, At, B1); PG8_BAR; PG8_SCHED;
        }
        if (wr == 0) PG8_BAR;
        if constexpr (FP8) { asm volatile("s_nop 15\n\ts_nop 7" ::: "memory"); }
        E(acc, cur, wid);
        if (!has_next) break;
#pragma unroll
        for (int a = 0; a < 2; ++a)
#pragma unroll
            for (int b = 0; b < 2; ++b)
#pragma unroll
                for (int m = 0; m < 4; ++m)
#pragma unroll
                    for (int n = 0; n < 2; ++n) acc[a][b][m][n] = (f32x4){0.f, 0.f, 0.f, 0.f};
        cur = nxt; cA = nA; cB = nB; ++ui;
        if constexpr (GATHER) cur.sl = (const PG8_LAS float*)(lds + IDX_OFF + 2048 + (ui & 1) * 1024);
        if constexpr (GATHER) { vC0[0] = vN0[0]; vC0[1] = vN0[1]; vC1[0] = vN1[0]; vC1[1] = vN1[1]; }
        if (wr == 1) PG8_BAR;
    }
    PG8_WAIT_V(0);
    PG8_BAR;
#undef PG8_SA
#undef PG8_SB
#undef PG8_STAGE
#undef PG8_STA
#undef PG8_GIDX
#undef PG8_SDMA
#undef PG8_IDMA
#undef PG8_LDA
#undef PG8_LDB
#undef PG8_MMA
#undef PG8_CAT8
#undef PG8_WAIT_V
#undef PG8_WAIT_L
#undef PG8_BAR
#undef PG8_SCHED
}
}

namespace attn_body {
using bf16 = __hip_bfloat16;
using bf16x8 = __attribute__((ext_vector_type(8))) short;
using s16x4 = __attribute__((ext_vector_type(4))) short;
using f32x16 = __attribute__((ext_vector_type(16))) float;
using u32x4 = __attribute__((ext_vector_type(4))) unsigned;
constexpr int ASEQ = SEQ, D = 64, QP = QDIM, KP = KVDIM, OP = DM;
constexpr int NW = 8, QBLK = 32, QB = QBLK * NW, KVBLK = 64;
__device__ __forceinline__ int crow(int r, int hi) { return (r & 3) + 8 * (r >> 2) + 4 * hi; }
#define SBAR() __builtin_amdgcn_sched_barrier(0)
constexpr int NSLOT = 3, SLOTB = 8192;
constexpr int LDS_K = 0, LDS_V = NSLOT * SLOTB, LDS_WS = 2 * NSLOT * SLOTB, LDS_OST = LDS_WS + NW * 64 * 4, LDS_BYTES = LDS_OST + NW * 4096;
constexpr float C2 = pg8::ATT_C2;
__device__ __forceinline__ void glds16(const void* gsrc, unsigned lds_dst) { unsigned keep;
  asm volatile("s_mov_b32 %0, m0\n\ts_mov_b32 m0, %2\n\ts_nop 0\n\tglobal_load_lds_dwordx4 %1, off\n\ts_mov_b32 m0, %0" : "=&s"(keep) : "v"(gsrc), "s"(lds_dst) : "memory"); }
__device__ __forceinline__ float max3f(float a, float b, float c) { float r; asm("v_max3_f32 %0, %1, %2, %3" : "=v"(r) : "v"(a), "v"(b), "v"(c)); return r; }
__device__ __forceinline__ float max2f(float a, float b) { float r; asm("v_max_f32_e32 %0, %1, %2" : "=v"(r) : "v"(a), "v"(b)); return r; }
__device__ __forceinline__ float fadd_s(float a, float b) { float r; asm("v_add_f32_e32 %0, %1, %2" : "=v"(r) : "v"(a), "v"(b)); return r; }
__device__ __forceinline__ float fsub_s(float a, float b) { float r; asm("v_sub_f32_e32 %0, %1, %2" : "=v"(r) : "v"(a), "v"(b)); return r; }
typedef float f32x2_t __attribute__((ext_vector_type(2))); typedef __bf16 bf16x2_t __attribute__((ext_vector_type(2)));
__device__ __forceinline__ unsigned cvtpk_s(float lo, float hi) { f32x2_t v = {lo, hi}; bf16x2_t b = __builtin_convertvector(v, bf16x2_t); return __builtin_bit_cast(unsigned, b); }
#define WAIT_BAR(N) asm volatile("s_waitcnt vmcnt(" #N ") lgkmcnt(0)\n\ts_barrier" ::: "memory")

__device__ __forceinline__ void qkt(f32x16& p0, f32x16& p1, const char* Kslot, const bf16x8* qr, const f32x16& negm, int r32, int hi) {
  const char* kb = Kslot + hi * 1024 + r32 * 16;
  #pragma unroll
  for (int d0 = 0; d0 < 4; ++d0) {
    const bf16x8 b0 = *reinterpret_cast<const bf16x8*>(kb + d0 * 2048);
    const bf16x8 b1 = *reinterpret_cast<const bf16x8*>(kb + d0 * 2048 + 512);
    if (d0 == 0) { p0 = __builtin_amdgcn_mfma_f32_32x32x16_bf16(b0, qr[0], negm, 0, 0, 0); p1 = __builtin_amdgcn_mfma_f32_32x32x16_bf16(b1, qr[0], negm, 0, 0, 0); }
    else { p0 = __builtin_amdgcn_mfma_f32_32x32x16_bf16(b0, qr[d0], p0, 0, 0, 0); p1 = __builtin_amdgcn_mfma_f32_32x32x16_bf16(b1, qr[d0], p1, 0, 0, 0); } }
}
typedef __attribute__((address_space(3))) const char* lds_cptr;
typedef short v4i16_t __attribute__((ext_vector_type(4)));
__device__ __forceinline__ void kload8(bf16x8* kf, lds_cptr kp) {
  kf[0] = *(const __attribute__((address_space(3))) bf16x8*)(kp);        kf[1] = *(const __attribute__((address_space(3))) bf16x8*)(kp + 512);
  kf[2] = *(const __attribute__((address_space(3))) bf16x8*)(kp + 2048); kf[3] = *(const __attribute__((address_space(3))) bf16x8*)(kp + 2560);
  kf[4] = *(const __attribute__((address_space(3))) bf16x8*)(kp + 4096); kf[5] = *(const __attribute__((address_space(3))) bf16x8*)(kp + 4608);
  kf[6] = *(const __attribute__((address_space(3))) bf16x8*)(kp + 6144); kf[7] = *(const __attribute__((address_space(3))) bf16x8*)(kp + 6656);
}
__device__ __forceinline__ void kload2(bf16x8* kf, lds_cptr kp, int j) { kf[2 * j] = *(const __attribute__((address_space(3))) bf16x8*)(kp + j * 2048); kf[2 * j + 1] = *(const __attribute__((address_space(3))) bf16x8*)(kp + j * 2048 + 512); }
__device__ __forceinline__ s16x4 vtr(lds_cptr p) { return __builtin_bit_cast(s16x4, __builtin_amdgcn_ds_read_tr16_b64_v4i16((__attribute__((address_space(3))) v4i16_t*)p)); }
__device__ __forceinline__ float rowmax(const f32x16& p0, const f32x16& p1) {
  float a = max3f(p0[0], p0[1], p1[0]), b = max3f(p0[2], p0[3], p1[1]); a = max3f(a, p1[2], p1[3]);
  #pragma unroll
  for (int r = 4; r < 16; r += 4) { a = max3f(a, p0[r], p0[r + 1]); b = max3f(b, p0[r + 2], p0[r + 3]); a = max3f(a, p1[r], p1[r + 1]); b = max3f(b, p1[r + 2], p1[r + 3]); }
  const float m = max2f(a, b);
  auto rr = __builtin_amdgcn_permlane32_swap(__float_as_uint(m), __float_as_uint(m), false, false);
  return max2f(__uint_as_float(rr[0]), __uint_as_float(rr[1]));
}
__device__ __forceinline__ void pv(f32x16* o, int vb, bf16x8 pa0, bf16x8 pa1, bf16x8 pa2, bf16x8 pa3) {
  #pragma unroll
  for (int d0 = 0; d0 < 2; ++d0) { s16x4 lo[4], hi[4];
    #pragma unroll
    for (int ks = 0; ks < 4; ++ks) {
      asm volatile("ds_read_b64_tr_b16 %0,%1 offset:%c2" : "=&v"(lo[ks]) : "v"(vb), "i"(d0 * 4096 + ks * 1024) : "memory");
      asm volatile("ds_read_b64_tr_b16 %0,%1 offset:%c2" : "=&v"(hi[ks]) : "v"(vb), "i"(d0 * 4096 + ks * 1024 + 512) : "memory"); }
    asm volatile("s_waitcnt lgkmcnt(0)" ::: "memory"); SBAR();
    #define PK(k) (bf16x8){lo[k][0], lo[k][1], lo[k][2], lo[k][3], hi[k][0], hi[k][1], hi[k][2], hi[k][3]}
    o[d0] = __builtin_amdgcn_mfma_f32_32x32x16_bf16(pa0, PK(0), o[d0], 0, 0, 0);
    o[d0] = __builtin_amdgcn_mfma_f32_32x32x16_bf16(pa1, PK(1), o[d0], 0, 0, 0);
    o[d0] = __builtin_amdgcn_mfma_f32_32x32x16_bf16(pa2, PK(2), o[d0], 0, 0, 0);
    o[d0] = __builtin_amdgcn_mfma_f32_32x32x16_bf16(pa3, PK(3), o[d0], 0, 0, 0);
    #undef PK
  }
}
#define ATTN_STORE16(p, v) (*(u32x4*)(p) = (v))
typedef int v4i_ __attribute__((ext_vector_type(4))); typedef int v8i_ __attribute__((ext_vector_type(8)));
template <int THRL> __device__ __forceinline__ void attn_unit(int b, int h, int qb, const unsigned char* Q8, const unsigned char* __restrict__ K8, const unsigned char* __restrict__ VT, bf16* O, char* shm, const int wid) {
  const int lane = opaque_lane(), r32 = lane & 31, hi = lane >> 5;
  const long rowbase = (long)b * ASEQ; const int q0 = qb * QB; const int kvh = h >> 2;
  const unsigned char* Qw = Q8 + (size_t)(rowbase + q0 + wid * QBLK) * QP + h * D;
  const unsigned char* Kh = K8 + (size_t)rowbase * KP + kvh * D; const unsigned char* Vh = VT + (size_t)(b * KVH + kvh) * (ASEQ / KVBLK) * 4096;
  const unsigned lds0 = (unsigned)(uintptr_t)shm;
  float* wsf = (float*)(shm + LDS_WS) + wid * 64;
  static_assert(THRL < 0, "the lazy-rescale path needs the one-barrier-per-tile loop");
  const int vL = wid * 64 + lane, vrow = vL >> 2, vsw = ((vL & 3) ^ ((vrow >> 1) & 3)) * 16;
  const unsigned char* vsrc = Vh + vrow * 64 + vsw;
  const unsigned char* ksrc = Kh + (size_t)vrow * KP + vsw;
  const unsigned kdst = lds0 + LDS_K + wid * 1024, vdst = lds0 + LDS_V + wid * 1024;
  #define DMA_K(T_, slot) glds16(ksrc + (long)(T_) * 2 * KVBLK * KP, (unsigned)__builtin_amdgcn_readfirstlane(kdst + (slot)))
  #define DMA_V(T_, slot) glds16(vsrc + (long)(T_) * 8192, (unsigned)__builtin_amdgcn_readfirstlane(vdst + (slot)))
  v4i_ kq0, kq1, kq2, kq3;
  const lds_cptr shm3 = (lds_cptr)shm; const int vc0 = (2 * hi) ^ ((r32 >> 1) & 3); const lds_cptr vp0 = shm3 + LDS_V + r32 * 64 + vc0 * 16, vp1 = shm3 + LDS_V + r32 * 64 + (vc0 ^ 1) * 16; const lds_cptr kp0 = vp0 + (LDS_K - LDS_V), kp1 = vp1 + (LDS_K - LDS_V);
  constexpr int NT = ASEQ / KVBLK;
  DMA_K(0, 0); DMA_V(0, 0); DMA_K(1, SLOTB);
  const v8i_ qv = __builtin_shufflevector(*reinterpret_cast<const v4i_*>(Qw + (size_t)r32 * QP + hi * 32), *reinterpret_cast<const v4i_*>(Qw + (size_t)r32 * QP + hi * 32 + 16), 0, 1, 2, 3, 4, 5, 6, 7);
  #define KQR(i, sl) do { kq##i = *(const __attribute__((address_space(3))) v4i_*)((((i) & 1) ? kp1 : kp0) + (sl) + ((i) >> 1) * 2048); } while (0)
  #define KCAT(a, b) __builtin_shufflevector(a, b, 0, 1, 2, 3, 4, 5, 6, 7)
  #define MFQK(a, b, c) __builtin_amdgcn_mfma_scale_f32_32x32x64_f8f6f4(a, b, c, 0, 0, 0, 0x7F7F7F7F, 0, 0x7E7E7E7E  )
  float mhat = 0.f; f32x16 o[2], osum = f32x16{}; o[0] = f32x16{}; o[1] = f32x16{}; v8i_ vones; _Pragma("unroll") for (int r = 0; r < 8; ++r) vones[r] = 0x38383838; asm volatile("" : "+v"(vones)); f32x16 negm; _Pragma("unroll") for (int r = 0; r < 16; ++r) negm[r] = 52.5f; asm volatile("" : "+v"(negm));
  #define CMASK(P0, P1, t) do {} while (0)
  bool resc = false;
  #define START(P0, P1) do { const float rm = rowmax(P0, P1); resc = false; \
    { const float dl = rm; mhat = fadd_s(mhat, dl); \
      _Pragma("unroll") for (int r = 0; r < 16; ++r) { P0[r] = fsub_s(P0[r], dl); P1[r] = fsub_s(P1[r], dl); } \
      _Pragma("unroll") for (int r = 0; r < 16; ++r) negm[r] = -mhat; asm volatile("" : "+v"(negm)); } \
    _Pragma("unroll") for (int r = 0; r < 16; ++r) P0[r] = __builtin_amdgcn_exp2f(P0[r]); } while (0)
  #define RESC() do { if (THRL >= 0 && resc) { asm volatile("s_waitcnt lgkmcnt(0)" ::: "memory"); \
      _Pragma("unroll") for (int d_ = 0; d_ < 2; ++d_) _Pragma("unroll") for (int r = 0; r < 16; ++r) o[d_][r] *= wsf[crow(r, hi)]; } } while (0)
  f32x16 pA0, pA1, pB0, pB1;
  int s0 = 2 * SLOTB, s1 = 0, s2 = SLOTB;
  #define ROT() do { const int s_ = s0; s0 = s1; s1 = s2; s2 = s_; } while (0)
  DMA_K(2, 2 * SLOTB); DMA_V(1, SLOTB);
  WAIT_BAR(2);
  KQR(0, 0); KQR(1, 0); KQR(2, 0); KQR(3, 0); pA0 = MFQK(KCAT(kq0, kq1), qv, negm); pA1 = MFQK(KCAT(kq2, kq3), qv, negm); CMASK(pA0, pA1, 0);
  KQR(0, 4096); KQR(1, 4096); KQR(2, 4096); KQR(3, 4096);
  v4i_ vq0, vq1, vq2, vq3; unsigned pq0 = 0u, pq1 = 0u, pq2 = 0u, pq3 = 0u, pq4 = 0u, pq5 = 0u, pq6 = 0u, pq7 = 0u;
  #define PK8(P, B, old, hw) __builtin_amdgcn_cvt_pk_u8_f32(P[(B) + 1], (hw) ? 3u : 1u, __builtin_amdgcn_cvt_pk_u8_f32(P[B], (hw) ? 2u : 0u, (unsigned)(old)))
  #define PQV() (v8i_){(int)pq0, (int)pq1, (int)pq2, (int)pq3, (int)pq4, (int)pq5, (int)pq6, (int)pq7}
  #define VCAT(a, b) __builtin_shufflevector(a, b, 0, 1, 2, 3, 4, 5, 6, 7)
  #define MFMA8(a, b, c) __builtin_amdgcn_mfma_scale_f32_32x32x64_f8f6f4(a, b, c, 1  , 0  , 0, 0, 0, 0)
  #define VQR(i, sl) do { vq##i = *(const __attribute__((address_space(3))) v4i_*)((((i) & 1) ? vp1 : vp0) + (sl) + ((i) >> 1) * 2048); } while (0)
  #define PIN(x) asm volatile("" : "+v"(x))
  #define MX3(a, b, c) __builtin_fmaxf(__builtin_fmaxf((a), (b)), (c))
  #define GAPA(MF, A0, A1, A2, A3, W0, W1, PW) do { MF; W0; W1; PIN(PW); SBAR(); } while (0)
  #define EX(v) __builtin_amdgcn_exp2f(v)
  #define GAPB(MF, X, B) do { MF; X[B] = EX(X[B]); X[B + 1] = EX(X[B + 1]); X[B + 2] = EX(X[B + 2]); X[B + 3] = EX(X[B + 3]); PIN(X); SBAR(); } while (0)
  #define EXG(X, B) do { } while (0)
  #define KRD(G, j) do { if (G) { KQR(j, ko_); SBAR(); } } while (0)
  #define STEP(C0, C1, P0, P1, VO, KO, DMAS, GL) do { SBAR(); const int vo_ = (VO), ko_ = (KO); (void)ko_; \
    VQR(0, vo_); SBAR(); \
    C0 = MFQK(KCAT(kq0, kq1), qv, negm); SBAR(); \
    GAPA((void)0, P0[2], P0[3], P0[4], P0[5],     pq0 = PK8(P0, 0, pq0, false), pq0 = PK8(P0, 2, pq0, true), pq0); \
    VQR(1, vo_); SBAR(); GAPA((void)0, P0[6], P0[7], P0[8], P0[9],     pq1 = PK8(P0, 4, pq1, false), pq1 = PK8(P0, 6, pq1, true), pq1); \
    VQR(2, vo_); SBAR(); GAPA((void)0, P0[10], P0[11], P0[12], P0[13], pq2 = PK8(P0, 8, pq2, false), pq2 = PK8(P0, 10, pq2, true), pq2); \
    VQR(3, vo_); SBAR(); GAPA((void)0, P0[14], P0[15], P1[0], P1[1],   pq3 = PK8(P0, 12, pq3, false), pq3 = PK8(P0, 14, pq3, true), pq3); \
    C1 = MFQK(KCAT(kq2, kq3), qv, negm); SBAR(); \
    GAPA((void)0, P1[2], P1[3], P1[4], P1[5],     pq4 = PK8(P1, 0, pq4, false), pq4 = PK8(P1, 2, pq4, true), pq4); \
    GAPA((void)0, P1[6], P1[7], P1[8], P1[9],     pq5 = PK8(P1, 4, pq5, false), pq5 = PK8(P1, 6, pq5, true), pq5); \
    GAPA((void)0, P1[10], P1[11], P1[12], P1[13], pq6 = PK8(P1, 8, pq6, false), pq6 = PK8(P1, 10, pq6, true), pq6); \
    GAPA((void)0, P1[14], P1[15], 0.f, 0.f,       pq7 = PK8(P1, 12, pq7, false), pq7 = PK8(P1, 14, pq7, true), pq7); \
    DMAS; \
    CMASK(C0, C1, 0); \
    if constexpr (THRL >= 0) { float a = MX3(C0[0], C0[1], C1[0]), b = MX3(C0[2], C0[3], C1[1]); a = MX3(a, C1[2], C1[3]); \
      _Pragma("unroll") for (int r = 4; r < 16; r += 4) { a = MX3(a, C0[r], C0[r + 1]); b = MX3(b, C0[r + 2], C0[r + 3]); a = MX3(a, C1[r], C1[r + 1]); b = MX3(b, C1[r + 2], C1[r + 3]); } \
      float rm = __builtin_fmaxf(a, b); { auto rr = __builtin_amdgcn_permlane32_swap(__float_as_uint(rm), __float_as_uint(rm), false, false); rm = __builtin_fmaxf(__uint_as_float(rr[0]), __uint_as_float(rr[1])); } \
      resc = false; \
      if (__builtin_expect(__any(rm > (float)THRL), 0)) { const float dl = __builtin_fmaxf(rm, 0.f); mhat += dl; \
        _Pragma("unroll") for (int r = 0; r < 16; ++r) { C0[r] -= dl; C1[r] -= dl; } \
        _Pragma("unroll") for (int r = 0; r < 16; ++r) negm[r] = -mhat; asm volatile("" : "+v"(negm)); \
        const float f = __builtin_amdgcn_exp2f(-dl); if (hi == 0) wsf[r32] = f; resc = true; } } \
    SBAR(); \
    { const v8i_ pa_ = PQV(); \
      o[0] = MFMA8(pa_, VCAT(vq0, vq1), o[0]); SBAR(); EXG(C0, 0); EXG(C0, 4); KRD(GL, 0); EXG(C0, 8); KRD(GL, 1); EXG(C0, 12); \
      o[1] = MFMA8(pa_, VCAT(vq2, vq3), o[1]); SBAR(); KRD(GL, 2); EXG(C1, 0); KRD(GL, 3); EXG(C1, 4); \
      osum = MFMA8(pa_, vones, osum); SBAR(); EXG(C1, 8); EXG(C1, 12); } \
    } while (0)
  constexpr int NS = NT / 2;
  STEP(pB0, pB1, pA0, pA1, s1, s2, (void)0, true);
  WAIT_BAR(0); ROT();
  for (int T_ = 1; T_ + 2 < NS; ++T_) {
    STEP(pA0, pA1, pB0, pB1, s0 + 4096, s1 + 4096, DMA_K(T_ + 2, s0); DMA_V(T_ + 1, s2), true);
    STEP(pB0, pB1, pA0, pA1, s1, s2, (void)0, true);
    WAIT_BAR(0); ROT();
  }
  STEP(pA0, pA1, pB0, pB1, s0 + 4096, s1 + 4096, DMA_V(NS - 1, s2), true);
  STEP(pB0, pB1, pA0, pA1, s1, s2, (void)0, true);
  WAIT_BAR(0); ROT();
  STEP(pA0, pA1, pB0, pB1, s0 + 4096, s1 + 4096, (void)0, true);
  STEP(pB0, pB1, pA0, pA1, s1, s2, (void)0, false);
  {
    pq0 = PK8(pB0, 0, pq0, false); pq0 = PK8(pB0, 2, pq0, true); pq1 = PK8(pB0, 4, pq1, false); pq1 = PK8(pB0, 6, pq1, true); pq2 = PK8(pB0, 8, pq2, false); pq2 = PK8(pB0, 10, pq2, true); pq3 = PK8(pB0, 12, pq3, false); pq3 = PK8(pB0, 14, pq3, true);
    pq4 = PK8(pB1, 0, pq4, false); pq4 = PK8(pB1, 2, pq4, true); pq5 = PK8(pB1, 4, pq5, false); pq5 = PK8(pB1, 6, pq5, true); pq6 = PK8(pB1, 8, pq6, false); pq6 = PK8(pB1, 10, pq6, true); pq7 = PK8(pB1, 12, pq7, false); pq7 = PK8(pB1, 14, pq7, true);
    SBAR(); VQR(0, s1 + 4096); VQR(1, s1 + 4096); VQR(2, s1 + 4096); VQR(3, s1 + 4096);
    { const v8i_ pa_ = PQV(); o[0] = MFMA8(pa_, VCAT(vq0, vq1), o[0]); o[1] = MFMA8(pa_, VCAT(vq2, vq3), o[1]); osum = MFMA8(pa_, vones, osum); } }
  #undef PK8
  #undef PQV
  #undef VCAT
  #undef MFMA8
  #undef VQR
  #undef EXG
  #undef PIN
  #undef MX3
  #undef GAPA
  #undef GAPB
  #undef EX
  #undef KRD
  #undef KQR
  #undef KCAT
  #undef MFQK
  #undef STEP
  #undef ENDW
  float rli[16];
  #pragma unroll
  for (int r = 0; r < 16; ++r) rli[r] = __builtin_amdgcn_rcpf(osum[r]);
  bf16* Ow = O + (rowbase + q0 + wid * QBLK) * OP + h * D;
  { bf16* stg = (bf16*)(shm + LDS_OST) + wid * 2048;
    #pragma unroll
    for (int r = 0; r < 16; ++r) { const int orow = crow(r, hi);
      #pragma unroll
      for (int d0 = 0; d0 < 2; ++d0) stg[orow * 64 + d0 * 32 + r32] = __float2bfloat16(o[d0][r] * rli[r]); }
    asm volatile("s_waitcnt lgkmcnt(0)" ::: "memory");
    #pragma unroll
    for (int i = 0; i < 4; ++i) { const int row = i * 8 + (lane >> 3), ch = lane & 7; const u32x4 v = *(const u32x4*)(stg + row * 64 + ch * 8); ATTN_STORE16(Ow + (long)row * OP + ch * 8, v); } }
  asm volatile("s_waitcnt lgkmcnt(0)\n\ts_barrier" ::: "memory");
  #undef DMA_K
  #undef DMA_V
  #undef CMASK
  #undef START
  #undef RESC
  #undef ROT
}
constexpr int ATTN_LDS_BYTES = LDS_BYTES;
#undef SBAR
#undef WAIT_BAR
}

constexpr int NWAVES = 8, NTHREADS = NWAVES * 64;
constexpr size_t MiB = 1u << 20;
constexpr size_t WS_CTL = 0, CTL_ZERO_BYTES = 1 * MiB;
constexpr size_t WS_ROPE = 1 * MiB;
constexpr size_t WS_ROWSS = 5 * MiB;
constexpr size_t WS_TOK = 7 * MiB;
constexpr size_t WS_TMAP = 9 * MiB;
constexpr size_t WS_SMAP = 11 * MiB;
constexpr size_t WS_PB = 972 * MiB;
constexpr size_t WS_WIN = 25 * MiB;
constexpr size_t WS_WOUT = 32 * MiB;
constexpr size_t WS_WFGU = 36 * MiB;
constexpr size_t WS_WFD = 58 * MiB;
constexpr size_t WS_WPOOL = 69 * MiB;
constexpr size_t WS_WPG = 70 * MiB;
constexpr size_t WS_WPP = 78 * MiB;
constexpr size_t WS_HB = 80 * MiB;
constexpr size_t WS_WMGU = 144 * MiB;
constexpr size_t WS_HQ = 208 * MiB;
constexpr size_t WS_WMD = 256 * MiB;
constexpr size_t WS_R = 312 * MiB;
constexpr size_t WS_Q = WS_R, WS_K = WS_R + 32 * MiB, WS_V = WS_R + 40 * MiB, WS_G = WS_R + 48 * MiB, WS_MIX = WS_R + 80 * MiB, WS_FFNH = WS_R + 144 * MiB;
constexpr size_t WS_YPOOL = WS_R, WS_XPERM = WS_R, WS_HID = WS_R + 132 * MiB;
constexpr size_t WS_HB2 = 906 * MiB;
constexpr size_t WS_PPLE_E = WS_HB2;
constexpr size_t WS_PPLE_O = WS_HB;
constexpr size_t WS_ROWSS2 = 970 * MiB;
constexpr size_t WS_END = 1036 * MiB;
static_assert(WS_HID + (size_t)XROWS * EXPD * 2 <= WS_HB2 && WS_FFNH + (size_t)T * FFN * 2 <= WS_HB2 && (size_t)XROWS * DM * 2 <= 132 * MiB, "d_ws map");
constexpr int CW_CNT = 64;
constexpr int CW_BAR = 4096;
constexpr int CW_LCG = 24576;
constexpr int CW_WGB = 16384;

#define GAS __attribute__((address_space(1)))
#define LAS __attribute__((address_space(3)))
typedef unsigned short bf16;
typedef unsigned v4u __attribute__((ext_vector_type(4)));
typedef unsigned v2u __attribute__((ext_vector_type(2)));
typedef float f32x4 __attribute__((ext_vector_type(4)));
#define LDS_WAIT() asm volatile("s_waitcnt lgkmcnt(0)" ::: "memory")
__device__ __forceinline__ unsigned f2bf(float f) { unsigned u = __builtin_bit_cast(unsigned, f); return (u + 0x7fffu + ((u >> 16) & 1u)) >> 16; }
__device__ __forceinline__ unsigned pk2(float lo, float hi) { return f2bf(lo) | (f2bf(hi) << 16); }
__device__ __forceinline__ float bflo(unsigned w) { return __uint_as_float(w << 16); }
__device__ __forceinline__ float bfhi(unsigned w) { return __uint_as_float(w & 0xffff0000u); }

#define XB_TMO      128
#define XB_XCNT(j)  (256  + 64 * (j))
#define XB_XSUB(j)  (1280 + 64 * (j))
#define XB_XGEN(j)  (2304 + 64 * (j))
#define XB_TOP      3328
#define XB_TOPGEN   3392
#define XCD_BAR_WORDS 3456
#define XB_SPIN_CAP (1u << 18)
__device__ __forceinline__ unsigned xb_ld(unsigned* p)              { return __hip_atomic_load(p, __ATOMIC_RELAXED, __HIP_MEMORY_SCOPE_AGENT); }
__device__ __forceinline__ unsigned xb_add(unsigned* p, unsigned v) { return __hip_atomic_fetch_add(p, v, __ATOMIC_RELAXED, __HIP_MEMORY_SCOPE_AGENT); }
__device__ __forceinline__ unsigned xb_xcc_id() { return (unsigned)__builtin_amdgcn_s_getreg((3 << 11) | 20) & 0xFu; }
#define XB_SPIN(cond, bar) do { unsigned _sp = 0; while (cond) { __builtin_amdgcn_s_sleep(1); \
    if ((++_sp & 255u) == 0u) { if (xb_ld(&(bar)[XB_TMO])) break; if (_sp > XB_SPIN_CAP) { atomicAdd(&(bar)[XB_TMO], 1u); break; } } } } while (0)
struct XcdBarrier { unsigned* bar; unsigned x; volatile LAS unsigned* st; };
__device__ __forceinline__ XcdBarrier xcd_barrier_post(unsigned* bar, volatile LAS unsigned* st, bool leader) {
    XcdBarrier b; b.bar = bar; b.x = xb_xcc_id(); b.st = st;
    if (leader) (void)xb_add(&bar[XB_XCNT(b.x)], 1u);
    return b;
}
__device__ __forceinline__ void xcd_barrier_complete(unsigned* bar, unsigned x, unsigned& nloc, unsigned& nx) {
    const unsigned G = gridDim.x * gridDim.y * gridDim.z;
    unsigned sum, cnt, mine, sp = 0u;
    for (;;) {
        sum = 0u; cnt = 0u; mine = 0u;
#pragma unroll
        for (unsigned j = 0; j < 16; ++j) { const unsigned c = xb_ld(&bar[XB_XCNT(j)]); sum += c; cnt += (c > 0u) ? 1u : 0u; mine = (j == x) ? c : mine; }
        if (sum == G) break;
        __builtin_amdgcn_s_sleep(1);
        if ((++sp & 255u) == 0u) { if (xb_ld(&bar[XB_TMO])) break; if (sp > XB_SPIN_CAP) { atomicAdd(&bar[XB_TMO], 1u); break; } }
    }
    nloc = mine > 0u ? mine : 1u; nx = cnt > 0u ? cnt : 1u;
}
__device__ __forceinline__ void xcd_barrier(const XcdBarrier& b, bool leader) {
    asm volatile("s_waitcnt vmcnt(0)" ::: "memory");
    __syncthreads();
    if (leader) {
        unsigned* bar = b.bar;
        __builtin_amdgcn_s_waitcnt(0);
        unsigned nloc = b.st[0], nx = b.st[1];
        if (nloc == 0u) { xcd_barrier_complete(bar, b.x, nloc, nx); b.st[0] = nloc; b.st[1] = nx; }
        const unsigned old = xb_add(&bar[XB_XSUB(b.x)], 1u);
        const unsigned gen = old / nloc;
        if (old + 1u == (gen + 1u) * nloc) {
            __builtin_amdgcn_fence(__ATOMIC_RELEASE, "agent");
            asm volatile("s_waitcnt vmcnt(0)" ::: "memory");
            const unsigned og = xb_add(&bar[XB_TOP], 1u);
            const unsigned tg = og / nx;
            if (og + 1u == (tg + 1u) * nx) xb_add(&bar[XB_TOPGEN], 1u);
            else XB_SPIN(xb_ld(&bar[XB_TOPGEN]) == tg, bar);
            __builtin_amdgcn_fence(__ATOMIC_ACQUIRE, "agent");
            xb_add(&bar[XB_XGEN(b.x)], 1u);
            asm volatile("s_waitcnt vmcnt(0)" ::: "memory");
        } else {
            XB_SPIN(xb_ld(&bar[XB_XGEN(b.x)]) == gen, bar);
            __builtin_amdgcn_fence(__ATOMIC_ACQUIRE, "agent");
            asm volatile("s_waitcnt vmcnt(0)" ::: "memory");
        }
    }
    __syncthreads();
}

constexpr int RING_BYTES = 131072, LDSCTL_OFF = RING_BYTES, MISC_OFF = LDSCTL_OFF + 320, LDS_BYTES = 147456;

struct Params {
    const float* in[24]; float* out; unsigned char* ws; int ph_lo, ph_hi;
};
enum { I_X = 0, I_P, I_NORM_MIX, I_NORM_FFN, I_W_IN, I_Q_NORM, I_K_NORM, I_CONV_W, I_CONV_B, I_CLN_G, I_CLN_B, I_W_OUT, I_FFN_WG, I_FFN_WU, I_FFN_WD,
       I_POOL_W, I_POOL_SCALE, I_ROUTER_W, I_MOE_WG, I_MOE_WU, I_MOE_WD, I_PLE_NORM, I_PLE_GATE_W, I_PLE_PROJ };

typedef const float* cfp_t;
#define CAS __attribute__((address_space(4)))
struct Frame {
    LAS unsigned char* lds; int tid, lane, wave, vcu, G, gw, NGW, bx;
    unsigned char* ws; const cfp_t* in; float* out;
};
typedef const struct Params* kparams_t;
__device__ __forceinline__ kparams_t kparams() { auto p = __builtin_amdgcn_kernarg_segment_ptr(); asm volatile("" : "+s"(p)); return (kparams_t)(const void*)p; }
__device__ __forceinline__ float wave_sum(float v, int lane) {
#pragma unroll
    for (int o = 1; o < 64; o <<= 1) v += shx(v, o, lane);
    return v;
}

constexpr float W_F8_SCALE = 64.0f;
struct TrItem { f32x4 v[8]; float kg[8]; f32x4 ns; };
__device__ __forceinline__ void transpose_load(TrItem& t, const float* W, int ldw, int k0, int n0, const float* kgain, const float* nscale, int lane) {
    const int c4 = (lane & 7) * 4, kr = lane >> 3;
    t.ns = (f32x4){1.f, 1.f, 1.f, 1.f}; if (nscale) t.ns = *(const f32x4*)(nscale + n0 + c4);
#pragma unroll
    for (int i = 0; i < 8; ++i) { t.v[i] = *(const f32x4*)(W + (size_t)(k0 + 8 * i + kr) * ldw + n0 + c4); t.kg[i] = kgain ? kgain[k0 + 8 * i + kr] : 1.0f; }
}
template <bool F8> __device__ __forceinline__ void transpose_finish(const TrItem& t, int k0, bf16* WT, int ldt, int drow0, LAS float* scr, int lane) {
    const int c4 = (lane & 7) * 4, kr = lane >> 3;
#pragma unroll
    for (int i = 0; i < 8; ++i) { LAS float* d = scr + (8 * i + kr) * 33 + c4; const f32x4 x = t.v[i] * t.ns * t.kg[i]; d[0] = x[0]; d[1] = x[1]; d[2] = x[2]; d[3] = x[3]; }
    LDS_WAIT(); asm volatile("" ::: "memory");
    const int c = lane & 7;
#pragma unroll
    for (int j = 0; j < 4; ++j) { const int n = (lane >> 3) + 8 * j; const LAS float* s = scr + (8 * c) * 33 + n;
        if (F8) { unsigned a = 0u, b = 0u;
            a = (unsigned)__builtin_amdgcn_cvt_pk_fp8_f32(s[0 * 33] * W_F8_SCALE, s[1 * 33] * W_F8_SCALE, (int)a, false); a = (unsigned)__builtin_amdgcn_cvt_pk_fp8_f32(s[2 * 33] * W_F8_SCALE, s[3 * 33] * W_F8_SCALE, (int)a, true);
            b = (unsigned)__builtin_amdgcn_cvt_pk_fp8_f32(s[4 * 33] * W_F8_SCALE, s[5 * 33] * W_F8_SCALE, (int)b, false); b = (unsigned)__builtin_amdgcn_cvt_pk_fp8_f32(s[6 * 33] * W_F8_SCALE, s[7 * 33] * W_F8_SCALE, (int)b, true);
            v2u o; o.x = a; o.y = b; *(GAS v2u*)((unsigned char*)WT + (size_t)(drow0 + n) * ldt + k0 + 8 * c) = o; }
        else { v4u o; o.x = pk2(s[0 * 33], s[1 * 33]); o.y = pk2(s[2 * 33], s[3 * 33]); o.z = pk2(s[4 * 33], s[5 * 33]); o.w = pk2(s[6 * 33], s[7 * 33]);
            *(GAS v4u*)(WT + (size_t)(drow0 + n) * ldt + k0 + 8 * c) = o; } }
    LDS_WAIT(); asm volatile("" ::: "memory");
}
template <int MAP> __device__ __forceinline__ int dest_row(int n) {
    if (MAP == 1) {
        if (n < 512) { const int h = n >> 6, d = n & 63; return (h >> 2) * 256 + (d >> 5) * 128 + (h & 3) * 32 + (d & 31); }
        if (n < 768) { const int c = n - 512, hh = c >> 6  , d = c & 63; return 512 + (d >> 5) * 128 + hh * 32 + (d & 31); }
        if (n < 1280) { const int c = n - 768; return 768 + (c >> 7) * 256 + (c & 127); } const int c = n - 1280; return 768 + (c >> 7) * 256 + 128 + (c & 127); }
    if (MAP == 2) return (n >> 7) * 256 + (n & 127);
    if (MAP == 3) return (n >> 7) * 256 + 128 + (n & 127);
    return n;
}
#ifndef DENSE_F8_MASK
#define DENSE_F8_MASK 2
#endif
__device__ __forceinline__ constexpr bool dense_f8(int j) { return (DENSE_F8_MASK >> j) & 1; }
template <int MAP, bool F8 = false> __device__ __forceinline__ void conv_matrix(Frame& F, const float* W, int K, int N, const float* kgain, const float* nscale, bf16* WT, int ldt) {
    LAS float* scr = (LAS float*)(F.lds + F.wave * 16384);
    const int nblk = N / 32, nitems = (K / 64) * nblk;
    int it = F.gw; if (it >= nitems) return;
    TrItem ta; transpose_load(ta, W, N, 64 * (it / nblk), 32 * (it % nblk), kgain, nscale, F.lane);
#pragma nounroll
    for (;;) {
        const int nx = it + F.NGW; const bool more = nx < nitems; TrItem tb; if (more) transpose_load(tb, W, N, 64 * (nx / nblk), 32 * (nx % nblk), kgain, nscale, F.lane);
        asm volatile("" ::: "memory");
        transpose_finish<F8>(ta, 64 * (it / nblk), WT, ldt, dest_row<MAP>(32 * (it % nblk)), scr, F.lane); if (!more) break; it = nx; ta = tb;
    }
}
__device__ __forceinline__ void moe_convert(Frame& F, int j) {
    const float* g = F.in[I_NORM_FFN] + (2 * j + 1) * DM;
    for (int e = 0; e < NEXP; ++e) {
        const size_t we = (size_t)(j * NEXP + e) * DM * EXPD;
        bf16* gu = (bf16*)((unsigned char*)(F.ws + WS_WMGU) + (size_t)e * (2 * EXPD) * DM);
        conv_matrix<2, true>(F, F.in[I_MOE_WG] + we, DM, EXPD, g, nullptr, gu, DM);
        conv_matrix<3, true>(F, F.in[I_MOE_WU] + we, DM, EXPD, g, nullptr, gu, DM);
        conv_matrix<0, true>(F, F.in[I_MOE_WD] + we, EXPD, DM, nullptr, nullptr, (bf16*)((unsigned char*)(F.ws + WS_WMD) + (size_t)e * DM * EXPD), EXPD);
    }
}
__device__ __forceinline__ void light_cus(const Frame& F, int nwg, int& nl, int& li) {
    const int rounds = (nwg + F.G - 1) / F.G, nheavy = nwg - (rounds - 1) * F.G;
    if (nheavy >= F.G) { nl = F.G; li = F.bx; return; }
    nl = F.G - nheavy; li = F.bx - nheavy;
}
__device__ __forceinline__ void p_convert(Frame& F, int layer) {
    const float* p = F.in[I_P] + (size_t)layer * T * PLE; bf16* pb = (bf16*)(F.ws + WS_PB) + (size_t)layer * T * PLE;
    const size_t n8 = (size_t)T * PLE / 8;
    for (size_t i = (size_t)blockIdx.x * NTHREADS + F.tid; i < n8; i += (size_t)F.G * NTHREADS) {
        const f32x4 a = *(const f32x4*)(p + i * 8), b = *(const f32x4*)(p + i * 8 + 4);
        v4u o; o.x = pk2(a[0], a[1]); o.y = pk2(a[2], a[3]); o.z = pk2(b[0], b[1]); o.w = pk2(b[2], b[3]); *(v4u*)(pb + i * 8) = o; }
}
__device__ __forceinline__ void row_out(Frame& F, size_t row, const f32x4 (&v)[4], bf16* hbase, float* rsbase) {
    bf16* hb = hbase + row * DM; float* rowss = rsbase + row * 16; float ss = 0.f;
#pragma unroll
    for (int j = 0; j < 4; ++j) { ss += (v[j][0] * v[j][0] + v[j][1] * v[j][1]) + (v[j][2] * v[j][2] + v[j][3] * v[j][3]);
        v2u o; o.x = pk2(v[j][0], v[j][1]); o.y = pk2(v[j][2], v[j][3]); *(v2u*)(hb + 4 * F.lane + 256 * j) = o; }
    ss = wave_sum(ss, F.lane);
    if (F.lane < 16) rowss[F.lane] = F.lane == 0 ? ss : 0.f;
}

__device__ __forceinline__ void p0_prologue(Frame& F) {
    for (int j = 0; j < 2; ++j) {
        conv_matrix<1>(F, F.in[I_W_IN] + (size_t)j * DM * INPROJ, DM, INPROJ, F.in[I_NORM_MIX] + (2 * j) * DM, nullptr, (bf16*)(F.ws + WS_WIN) + (size_t)j * INPROJ * DM, DM);
        conv_matrix<0>(F, F.in[I_W_OUT] + (size_t)j * DM * DM, DM, DM, nullptr, nullptr, (bf16*)(F.ws + WS_WOUT) + (size_t)j * DM * DM, DM);
        if (dense_f8(j)) {
        conv_matrix<2, true>(F, F.in[I_FFN_WG] + (size_t)j * DM * FFN, DM, FFN, F.in[I_NORM_FFN] + (2 * j) * DM, nullptr, (bf16*)(F.ws + WS_WFGU) + (size_t)j * 2 * FFN * DM, DM);
        conv_matrix<3, true>(F, F.in[I_FFN_WU] + (size_t)j * DM * FFN, DM, FFN, F.in[I_NORM_FFN] + (2 * j) * DM, nullptr, (bf16*)(F.ws + WS_WFGU) + (size_t)j * 2 * FFN * DM, DM);
        conv_matrix<0, true>(F, F.in[I_FFN_WD] + (size_t)j * FFN * DM, FFN, DM, nullptr, nullptr, (bf16*)(F.ws + WS_WFD) + (size_t)j * DM * FFN, FFN);
        } else {
        conv_matrix<2>(F, F.in[I_FFN_WG] + (size_t)j * DM * FFN, DM, FFN, F.in[I_NORM_FFN] + (2 * j) * DM, nullptr, (bf16*)(F.ws + WS_WFGU) + (size_t)j * 2 * FFN * DM, DM);
        conv_matrix<3>(F, F.in[I_FFN_WU] + (size_t)j * DM * FFN, DM, FFN, F.in[I_NORM_FFN] + (2 * j) * DM, nullptr, (bf16*)(F.ws + WS_WFGU) + (size_t)j * 2 * FFN * DM, DM);
        conv_matrix<0>(F, F.in[I_FFN_WD] + (size_t)j * FFN * DM, FFN, DM, nullptr, nullptr, (bf16*)(F.ws + WS_WFD) + (size_t)j * DM * FFN, FFN);
        }
        for (int g = 0; g < 4; ++g)
            conv_matrix<0>(F, F.in[I_POOL_W] + (size_t)(j * 4 + g) * 65536, 256, 256, F.in[I_NORM_MIX] + (2 * j + 1) * DM + g * 256, F.in[I_POOL_SCALE] + j * DM + g * 256, (bf16*)(F.ws + WS_WPOOL) + (size_t)(j * 4 + g) * 65536, 256);
    }
    for (int i = 0; i < DEPTH; ++i) {
        conv_matrix<0>(F, F.in[I_PLE_GATE_W] + (size_t)i * DM * DM, DM, DM, F.in[I_PLE_NORM] + i * DM, nullptr, (bf16*)(F.ws + WS_WPG) + (size_t)i * DM * DM, DM);
        conv_matrix<0>(F, F.in[I_PLE_PROJ] + (size_t)i * PLE * DM, PLE, DM, nullptr, nullptr, (bf16*)(F.ws + WS_WPP) + (size_t)i * DM * PLE, PLE);
    }
    moe_convert(F, 0);
    for (int i = 0; i < DEPTH; ++i) p_convert(F, i);
    { float* ct = (float*)(F.ws + WS_ROPE); float* st = ct + SEQ * 32;
      for (int i = blockIdx.x * NTHREADS + F.tid; i < SEQ * 32; i += F.G * NTHREADS) { const int s = i >> 5, k = i & 31, jj = k & 15;
          const float inv = powf(10000.0f, -(float)jj / 16.0f); const float pos = (float)(k < 16 ? (s >> 6) : (s & 63)); const float ang = pos * inv;
          ct[i] = cosf(ang); st[i] = sinf(ang); } }
    for (int m = F.gw; m < T; m += F.NGW) { const float* xr = F.in[I_X] + (size_t)m * DM; f32x4 v[4];
#pragma unroll
        for (int j = 0; j < 4; ++j) v[j] = *(const f32x4*)(xr + 4 * F.lane + 256 * j);
        row_out(F, m, v, (bf16*)(F.ws + WS_HB), (float*)(F.ws + WS_ROWSS)); }
}

__device__ __forceinline__ float reduce16(float (&v)[16], int lane);
__device__ __forceinline__ void conv_phase(Frame& F, int j) {
    constexpr int TT = 32, RW = TT + 30;
    LAS unsigned short* xin = (LAS unsigned short*)F.lds;
    LAS float* red = (LAS float*)(F.lds + 65536);
    LAS float* stt = (LAS float*)(F.lds + 65536 + 8 * TT * 2 * 4);
    const bf16* Gb = (const bf16*)(F.ws + WS_G); bf16* mix = (bf16*)(F.ws + WS_MIX);
    const int c = F.tid;
    float w[CONVW];
#pragma unroll
    for (int k = 0; k < CONVW; ++k) w[k] = F.in[I_CONV_W][(size_t)(j * CONVW + k) * CONVC + c];
    const float cb = F.in[I_CONV_B][j * CONVC + c], lg = F.in[I_CLN_G][j * CONVC + c], lb = F.in[I_CLN_B][j * CONVC + c];
    const int nunits = T / TT;
    v4u vv[8];
#define CONV_LOAD(u_) do { const int b_ = (u_) / (SEQ / TT), t0_ = ((u_) % (SEQ / TT)) * TT; \
        _Pragma("unroll") for (int i = 0; i < 8; ++i) { const int ch = F.tid + i * NTHREADS, r = ch >> 6, cc = ch & 63, t = t0_ - 15 + r; \
            vv[i] = (v4u){0u, 0u, 0u, 0u}; if (ch < RW * 64 && t >= 0 && t < SEQ) vv[i] = *(const v4u*)(Gb + ((size_t)b_ * SEQ + t) * CONVC + cc * 8); } } while (0)
    int u = F.vcu; if (u < nunits) CONV_LOAD(u);
    for (; u < nunits; u += F.G) {
        const int b = u / (SEQ / TT), t0 = (u % (SEQ / TT)) * TT;
#pragma unroll
        for (int i = 0; i < 8; ++i) { const int ch = F.tid + i * NTHREADS; if (ch < RW * 64) *(LAS v4u*)(xin + (ch >> 6) * 512 + (ch & 63) * 8) = vv[i]; }
        __syncthreads();
        float x[RW];
#pragma unroll
        for (int r = 0; r < RW; ++r) x[r] = __uint_as_float((unsigned)xin[r * 512 + c] << 16);
        asm volatile("s_waitcnt lgkmcnt(0)" ::: "memory");
        { const int un = u + F.G; if (un < nunits) CONV_LOAD(un); }
        float uo[TT];
#pragma unroll
        for (int tt = 0; tt < TT; ++tt) { float a = cb;
#pragma unroll
            for (int k = 0; k < CONVW; ++k) a += w[k] * x[tt + k];
            uo[tt] = a; }
#pragma unroll
        for (int h = 0; h < 2; ++h) { float v1[16], v2[16];
#pragma unroll
            for (int i = 0; i < 16; ++i) { v1[i] = uo[16 * h + i]; v2[i] = uo[16 * h + i] * uo[16 * h + i]; }
            const float s1 = reduce16(v1, F.lane), s2 = reduce16(v2, F.lane);
            if ((F.lane & 3) == 0) { LAS float* rp = red + (F.wave * TT + 16 * h + ((F.lane >> 2) & 15)) * 2; rp[0] = s1; rp[1] = s2; } }
        __syncthreads();
        if (F.tid < TT) { float s1 = 0.f, s2 = 0.f;
#pragma unroll
            for (int wv = 0; wv < 8; ++wv) { s1 += red[(wv * TT + F.tid) * 2]; s2 += red[(wv * TT + F.tid) * 2 + 1]; }
            const float mu = s1 * (1.0f / CONVC); float var = s2 * (1.0f / CONVC) - mu * mu; var = var > 0.f ? var : 0.f;
            stt[F.tid * 2] = mu; stt[F.tid * 2 + 1] = 1.0f / sqrtf(var + EPS); }
        __syncthreads();
#pragma unroll
        for (int tt = 0; tt < TT; ++tt) { const float y = (uo[tt] - stt[tt * 2]) * stt[tt * 2 + 1] * lg + lb; const float o = y * pg8::fsigmoid(y);
            mix[((size_t)b * SEQ + t0 + tt) * DM + QDIM + c] = (bf16)f2bf(o); }
        __syncthreads();
    }
#undef CONV_LOAD
}

__device__ __forceinline__ void load8(const bf16* p, float sc, float (&x)[8]) {
    const v4u w = *(const v4u*)p;
    x[0] = sc * bflo(w.x); x[1] = sc * bfhi(w.x); x[2] = sc * bflo(w.y); x[3] = sc * bfhi(w.y); x[4] = sc * bflo(w.z); x[5] = sc * bfhi(w.z); x[6] = sc * bflo(w.w); x[7] = sc * bfhi(w.w);
}
__device__ __forceinline__ void pool_stencil(Frame& F, const bf16* hb, const float* rowss) {
    constexpr int TT = 128, R0 = 8, RW = TT + 16, TP = TT / 4;
    LAS float* srow = (LAS float*)F.lds;
    bf16* yp = (bf16*)(F.ws + WS_YPOOL);
    const int c = (F.tid & 127) * 8, g = c >> 8, wdw = 2 << g, left = wdw >> 1, right = wdw - 1 - left, part = F.tid >> 7;
    const int nunits = T / TT;
    for (int u = F.vcu; u < nunits; u += F.G) {
        const int b = u / (SEQ / TT), t0 = (u % (SEQ / TT)) * TT;
        const bf16* xb = hb + (size_t)b * SEQ * DM + c; bf16* yb = yp + (size_t)b * SEQ * DM + c;
        if (F.tid < RW) { const int t = t0 - R0 + F.tid; float sv = 0.f;
            if (t >= 0 && t < SEQ) { const float* rs = rowss + ((size_t)b * SEQ + t) * 16; float ss = 0.f;
#pragma unroll
                for (int q = 0; q < 16; ++q) ss += rs[q];
                sv = 1.0f / sqrtf(ss * (1.0f / DM) + EPS); }
            srow[F.tid] = sv; }
        __syncthreads();
        const int tb = t0 + part * TP;
        float S[8];
#pragma unroll
        for (int e = 0; e < 8; ++e) S[e] = 0.f;
#pragma unroll
        for (int q = -8; q <= 7; ++q) {
            const int r = tb + q; const bool in = (q >= -left) && (q <= right); const int rc = r < 0 ? 0 : (r > SEQ - 1 ? SEQ - 1 : r);
            const float sc = in ? srow[r - t0 + R0] : 0.f; float x[8]; load8(xb + (size_t)rc * DM, sc, x);
#pragma unroll
            for (int e = 0; e < 8; ++e) S[e] += x[e]; }
#pragma unroll 4
        for (int i = 0; i < TP; ++i) { const int t = tb + i;
            int lo = t - left, hi = t + right; lo = lo < 0 ? 0 : lo; hi = hi > SEQ - 1 ? SEQ - 1 : hi; const float ic = 1.0f / (float)(hi - lo + 1);
            float xc[8]; load8(xb + (size_t)t * DM, srow[t - t0 + R0], xc);
            v4u o; o.x = pk2(S[0] * ic - xc[0], S[1] * ic - xc[1]); o.y = pk2(S[2] * ic - xc[2], S[3] * ic - xc[3]); o.z = pk2(S[4] * ic - xc[4], S[5] * ic - xc[5]); o.w = pk2(S[6] * ic - xc[6], S[7] * ic - xc[7]);
            *(v4u*)(yb + (size_t)t * DM) = o;
            const int rn = t + 1 + right, ro = t - left;
            const int rnc = rn > SEQ - 1 ? SEQ - 1 : rn, roc = ro < 0 ? 0 : ro;
            float xn[8], xo[8]; load8(xb + (size_t)rnc * DM, srow[rn - t0 + R0], xn); load8(xb + (size_t)roc * DM, srow[ro - t0 + R0], xo);
#pragma unroll
            for (int e = 0; e < 8; ++e) S[e] += xn[e] - xo[e]; }
        __syncthreads();
    }
}

__device__ __forceinline__ float reduce16(float (&v)[16], int lane) {
#pragma unroll
    for (int i = 0; i < 8; ++i) { const bool up = lane & 32; const float snd = up ? v[i] : v[i + 8], kp = up ? v[i + 8] : v[i]; v[i] = kp + shx(snd, 32, lane); }
#pragma unroll
    for (int i = 0; i < 4; ++i) { const bool up = lane & 16; const float snd = up ? v[i] : v[i + 4], kp = up ? v[i + 4] : v[i]; v[i] = kp + shx(snd, 16, lane); }
#pragma unroll
    for (int i = 0; i < 2; ++i) { const bool up = lane & 8; const float snd = up ? v[i] : v[i + 2], kp = up ? v[i + 2] : v[i]; v[i] = kp + shx(snd, 8, lane); }
    { const bool up = lane & 4; const float snd = up ? v[0] : v[1], kp = up ? v[1] : v[0]; v[0] = kp + shx(snd, 4, lane); }
    v[0] += shx(v[0], 2, lane); v[0] += shx(v[0], 1, lane);
    return v[0];
}
__device__ __forceinline__ float rdlane(float v, int l) { return __int_as_float(__builtin_amdgcn_readlane(__float_as_int(v), l)); }
constexpr int RT_WTOT = 0, RT_ENT = 256, RT_ARR = 32768, RT_MISC = RT_ARR + 16384;
__device__ __forceinline__ void route_phase1(Frame& F, int j, const bf16* hb) {
    const float* g = F.in[I_NORM_FFN] + (2 * j + 1) * DM; const float* rw = F.in[I_ROUTER_W] + (size_t)j * DM * NEXP;
    LAS unsigned* wtot = (LAS unsigned*)(F.lds + RT_WTOT); LAS unsigned* ent = (LAS unsigned*)(F.lds + RT_ENT);
    unsigned cw[NEXP];
#pragma unroll
    for (int e = 0; e < NEXP; ++e) cw[e] = 0u;
    int nk = 0;
    f32x4 rwa[16], rwb[16];
#pragma unroll
    for (int q = 0; q < 4; ++q) { const int k0 = 4 * F.lane + 256 * q; const f32x4 gv = *(const f32x4*)(g + k0);
#pragma unroll
        for (int i = 0; i < 4; ++i) { rwa[4 * q + i] = *(const f32x4*)(rw + (size_t)(k0 + i) * NEXP) * gv[i]; rwb[4 * q + i] = *(const f32x4*)(rw + (size_t)(k0 + i) * NEXP + 4) * gv[i]; } }
    for (int m = F.gw; m < T; m += F.NGW, ++nk) {
        float v[16];
#pragma unroll
        for (int e = 0; e < 16; ++e) v[e] = 0.f;
#pragma unroll
        for (int q = 0; q < 4; ++q) { const int k0 = 4 * F.lane + 256 * q; const v2u hw = *(const v2u*)(hb + (size_t)m * DM + k0); const f32x4 hv = (f32x4){bflo(hw.x), bfhi(hw.x), bflo(hw.y), bfhi(hw.y)};
#pragma unroll
            for (int i = 0; i < 4; ++i) { const float x = hv[i]; v[8] += x * x; const f32x4 r0 = rwa[4 * q + i], r1 = rwb[4 * q + i];
                v[0] += x * r0[0]; v[1] += x * r0[1]; v[2] += x * r0[2]; v[3] += x * r0[3]; v[4] += x * r1[0]; v[5] += x * r1[1]; v[6] += x * r1[2]; v[7] += x * r1[3]; } }
        const float red = reduce16(v, F.lane);
        const float sv = 1.0f / sqrtf(rdlane(red, 32) * (1.0f / DM) + EPS);
        float lg[NEXP];
#pragma unroll
        for (int e = 0; e < NEXP; ++e) lg[e] = rdlane(red, 4 * e) * sv;
        int i0 = 0; float v0 = lg[0];
#pragma unroll
        for (int e = 1; e < NEXP; ++e) if (lg[e] > v0) { v0 = lg[e]; i0 = e; }
        int i1 = -1; float v1 = -INFINITY;
#pragma unroll
        for (int e = 0; e < NEXP; ++e) if (e != i0 && lg[e] > v1) { v1 = lg[e]; i1 = e; }
        const float p0 = 1.0f / (1.0f + expf(v1 - v0)), p1 = 1.0f - p0;
        unsigned lp0 = 0u, lp1 = 0u;
#pragma unroll
        for (int e = 0; e < NEXP; ++e) { if (e == i0) { lp0 = cw[e]; cw[e] += 1u; } if (e == i1) { lp1 = cw[e]; cw[e] += 1u; } }
        if (F.lane == 0 && nk < 64) { LAS unsigned* en = ent + (F.wave * 64 + nk) * 8; en[0] = (unsigned)m; en[1] = (unsigned)i0 | ((unsigned)i1 << 8); en[2] = lp0 | (lp1 << 16); en[3] = __float_as_uint(sv); en[4] = __float_as_uint(p0); en[5] = __float_as_uint(p1); }
    }
    { unsigned mine = 0u;
#pragma unroll
      for (int e = 0; e < NEXP; ++e) mine = (F.lane == e) ? cw[e] : mine;
      if (F.lane < NEXP) wtot[F.wave * NEXP + F.lane] = mine; }
    __syncthreads();
    if (F.tid < NEXP) { unsigned t = 0u;
#pragma unroll
        for (int w = 0; w < NWAVES; ++w) t += wtot[w * NEXP + F.tid];
        ((unsigned*)(F.ws + WS_CTL) + CW_LCG)[F.vcu * NEXP + F.tid] = t; }
}
__device__ __forceinline__ void route_phase2(Frame& F, int j) {
    unsigned* cnt = (unsigned*)(F.ws + WS_CTL) + CW_CNT + 64 * j; unsigned* tok = (unsigned*)(F.ws + WS_TOK); const unsigned* lcg = (const unsigned*)(F.ws + WS_CTL) + CW_LCG;
    unsigned* tmap = (unsigned*)(F.ws + WS_TMAP); float* smap = (float*)(F.ws + WS_SMAP);
    LAS unsigned* wtot = (LAS unsigned*)(F.lds + RT_WTOT); LAS unsigned* ent = (LAS unsigned*)(F.lds + RT_ENT); LAS unsigned* arr = (LAS unsigned*)(F.lds + RT_ARR);
    LAS unsigned* lbase = (LAS unsigned*)(F.lds + RT_MISC); LAS unsigned* woff = lbase + 8;
    for (int v = F.tid; v < F.G; v += NTHREADS) { const v4u a = *(const v4u*)(lcg + v * NEXP), b = *(const v4u*)(lcg + v * NEXP + 4); *(LAS v4u*)(arr + v * NEXP) = a; *(LAS v4u*)(arr + v * NEXP + 4) = b; }
    __syncthreads();
    { LAS unsigned* part = woff + 64;
      const int e = F.tid & 7, ch = F.tid >> 3, per = (F.G + 63) / 64; unsigned base = 0u, tot = 0u;
      for (int v = ch * per; v < (ch + 1) * per && v < F.G; ++v) { const unsigned c = arr[v * NEXP + e]; base += (v < F.vcu) ? c : 0u; tot += c; }
      part[(ch * NEXP + e) * 2] = base; part[(ch * NEXP + e) * 2 + 1] = tot;
      __syncthreads();
      if (F.tid < NEXP) { unsigned b2 = 0u, t2 = 0u;
          for (int c2 = 0; c2 < 64; ++c2) { b2 += part[(c2 * NEXP + F.tid) * 2]; t2 += part[(c2 * NEXP + F.tid) * 2 + 1]; }
          lbase[F.tid] = b2; lbase[1100 + F.tid] = t2; ((unsigned*)(F.ws + WS_CTL) + CW_WGB)[F.vcu * NEXP + F.tid] = b2; if (F.vcu == 0) cnt[F.tid] = t2; } }
    if (F.tid < NWAVES * NEXP) { const int w = F.tid >> 3, e = F.tid & 7; unsigned o = 0u;
        for (int q = 0; q < w; ++q) o += wtot[q * NEXP + e];
        woff[F.tid] = o; }
    __syncthreads();
    if (F.vcu < NEXP && F.tid < 256) { const unsigned tot = lbase[1100 + F.vcu], pos = tot + (unsigned)F.tid;
        if (pos < ((tot + 255u) & ~255u)) { tmap[(size_t)F.vcu * T + pos] = 0u; smap[(size_t)F.vcu * T + pos] = 0.f; } }
    const int nk = F.gw < T ? (T - 1 - F.gw) / F.NGW + 1 : 0;
    if (F.lane < nk && F.lane < 64) { const LAS unsigned* en = ent + (F.wave * 64 + F.lane) * 8; const unsigned m = en[0], ee = en[1], lp = en[2]; const float sv = __uint_as_float(en[3]);
        const unsigned e0 = ee & 255u, e1 = ee >> 8, w0 = woff[F.wave * NEXP + e0] + (lp & 0xffffu), w1 = woff[F.wave * NEXP + e1] + (lp >> 16), q0 = lbase[e0] + w0, q1 = lbase[e1] + w1;
        tmap[(size_t)e0 * T + q0] = m; smap[(size_t)e0 * T + q0] = sv; tmap[(size_t)e1 * T + q1] = m; smap[(size_t)e1 * T + q1] = sv;
        v4u a; a.x = ee; a.y = w0 | (w1 << 16); a.z = en[4]; a.w = en[5]; *(v4u*)(tok + (size_t)m * 4) = a; }
    __syncthreads();
}
__device__ __forceinline__ void tile_offsets(const unsigned* cnt, int (&toff)[NEXP + 1]) {
    toff[0] = 0;
#pragma unroll
    for (int e = 0; e < NEXP; ++e) toff[e + 1] = toff[e] + (int)((__hip_atomic_load(cnt + e, __ATOMIC_RELAXED, __HIP_MEMORY_SCOPE_AGENT) + 255u) >> 8);
}
__device__ __forceinline__ void combine_phase(Frame& F, int j, bf16* hbo, float* rso) {
    const unsigned* tok = (const unsigned*)(F.ws + WS_TOK); const bf16* yp = (const bf16*)(F.ws + WS_XPERM);
    LAS unsigned* ltoff = (LAS unsigned*)F.lds;
    if (F.tid == 0) { int toff[NEXP + 1]; tile_offsets((const unsigned*)(F.ws + WS_CTL) + CW_CNT + 64 * j, toff);
#pragma unroll
        for (int e = 0; e < NEXP; ++e) ltoff[e] = (unsigned)toff[e] * 256u; }
    __syncthreads();
    for (int m = F.gw; m < T; m += F.NGW) {
        const v4u a = *(const v4u*)(tok + (size_t)m * 4); const float p0 = __uint_as_float(a.z), p1 = __uint_as_float(a.w);
        const unsigned e0 = a.x & 255u, e1 = a.x >> 8; const unsigned* wgb = (const unsigned*)(F.ws + WS_CTL) + CW_WGB + ((m % F.NGW) >> 3) * NEXP;
        const size_t s0 = ltoff[e0] + wgb[e0] + (a.y & 0xffffu), s1 = ltoff[e1] + wgb[e1] + (a.y >> 16);
        f32x4 v[4];
#pragma unroll
        for (int q = 0; q < 4; ++q) { const int k0 = 4 * F.lane + 256 * q; const v2u hw = *(const v2u*)(hbo + (size_t)m * DM + k0); v[q] = (f32x4){bflo(hw.x), bfhi(hw.x), bflo(hw.y), bfhi(hw.y)};
            const v2u y0 = *(const v2u*)(yp + s0 * DM + k0), y1 = *(const v2u*)(yp + s1 * DM + k0);
            v[q][0] += p0 * bflo(y0.x) + p1 * bflo(y1.x); v[q][1] += p0 * bfhi(y0.x) + p1 * bfhi(y1.x); v[q][2] += p0 * bflo(y0.y) + p1 * bflo(y1.y); v[q][3] += p0 * bfhi(y0.y) + p1 * bfhi(y1.y); }
        row_out(F, m, v, hbo, rso);
    }
    __syncthreads();
}

struct DenseSched {
    pg8::GridOrder o; const char* A; const char* B; size_t astep, bstep;
    __device__ __forceinline__ bool next(int i, pg8::Unit& u) const { int pm, pn; if (!o.tile(i, pm, pn)) return false; u.pm = pm; u.pn = pn; u.e = 0; u.a = A + (size_t)pm * astep; u.b = B + (size_t)pn * bstep; return true; }
};
struct PoolSched {
    pg8::GridOrder o; const char* A; const char* B;
    __device__ __forceinline__ bool next(int i, pg8::Unit& u) const { int pm, pn; if (!o.tile(i, pm, pn)) return false; u.pm = pm; u.pn = pn; u.e = pn; u.a = A + ((size_t)pm * 256 * DM + pn * 256) * 2; u.b = B + (size_t)pn * 65536 * 2; return true; }
};
struct MoeSched {
    pg8::GridOrder o; const char* A; const char* B; size_t astep, wstride  , bstep; const LAS int* ltoff  ; const unsigned* tmap; const float* smap;
    __device__ __forceinline__ int counts(const unsigned* cnt, LAS int* tab) {
        int t = 0;
#pragma unroll
        for (int e = 0; e < NEXP; ++e) { tab[e] = t; t += (int)((__hip_atomic_load(cnt + e, __ATOMIC_RELAXED, __HIP_MEMORY_SCOPE_AGENT) + 255u) >> 8); }
        tab[NEXP] = t; ltoff = tab; __syncthreads(); return __builtin_amdgcn_readfirstlane(t); }
    __device__ __forceinline__ bool next(int i, pg8::Unit& u) const { int pm, pn; if (!o.tile(i, pm, pn)) return false; int e = 0, t0 = 0;
#pragma unroll
        for (int q = 1; q < NEXP; ++q) { const int tq = ltoff[q]; const bool ge = pm >= tq; e += ge ? 1 : 0; t0 = ge ? tq : t0; }
        e = __builtin_amdgcn_readfirstlane(e); t0 = __builtin_amdgcn_readfirstlane(t0);
        const int pos0 = (pm - t0) * 256;
        u.pm = pm; u.pn = pn; u.e = e; u.a = A + (size_t)pm * astep; u.b = B + (size_t)e * wstride + (size_t)pn * bstep;
        u.map = tmap + (size_t)e * T + pos0; u.srow = smap + (size_t)e * T + pos0; u.nvalid = 256; return true; }
};

constexpr int PH_PER_PAIR = 14, N_PHASES = 1 + 2 * PH_PER_PAIR;
__device__ __forceinline__ Frame mk_frame(LAS unsigned char* lds, const int wave) {
    kparams_t kp = kparams(); Frame F;
    { int w_ = wave; asm volatile("" : "+s"(w_)); F.wave = w_; }
    F.lds = lds; F.lane = opaque_lane(); F.tid = F.wave * 64 + F.lane;
    { int g_ = gridDim.x, b_ = blockIdx.x; asm volatile("" : "+s"(g_), "+s"(b_)); F.G = g_; F.bx = b_; }
    { const int bx = F.bx; F.vcu = (F.G % 8 == 0) ? (bx % 8) * (F.G / 8) + bx / 8 : bx; }
    F.gw = F.vcu * NWAVES + F.wave; F.NGW = F.G * NWAVES; F.ws = kp->ws; F.in = kp->in; F.out = kp->out;
    return F;
}
__device__ __forceinline__ void grid_bar(LAS unsigned char* lds, const int wave) {
    kparams_t kp = kparams(); XcdBarrier b; b.bar = (unsigned*)(kp->ws + WS_CTL) + CW_BAR; b.x = xb_xcc_id(); b.st = (volatile LAS unsigned*)(lds + MISC_OFF) + 8;
    xcd_barrier(b, wave == 0 && opaque_lane() == 0);
}
#ifndef PHMASK
#define PHMASK 0xFFFFFFFFu
#endif
#ifndef PROBE_REP
#define PROBE_REP 0u
#endif
#define PHASE(id, ...) do { kparams_t kp_ = kparams(); const int ph = ((id) == 0) ? 0 : PH_PER_PAIR * j + (id); const int lo = kp_->ph_lo, hi = kp_->ph_hi; \
    if (ph >= lo && ph < hi) { if constexpr ((PHMASK >> (id)) & 1u) { Frame F = mk_frame(ldsb, WV); unsigned char* const ws = F.ws; LAS unsigned char* const ring = F.lds; \
        bf16* const HB0 = (bf16*)(ws + WS_HB); bf16* const HB1 = (bf16*)(ws + WS_HB2); float* const RS0 = (float*)(ws + WS_ROWSS); float* const RS1 = (float*)(ws + WS_ROWSS2); \
        (void)HB0; (void)HB1; (void)RS0; (void)RS1; (void)ring; int nrep_ = ((((PROBE_REP) >> (id)) & 1u) ? 2 : 1); if constexpr (((PROBE_REP) >> (id)) & 1u) asm volatile("" : "+s"(nrep_)); _Pragma("nounroll") for (int rep_ = 0; rep_ < nrep_; ++rep_) { __VA_ARGS__; } } if (ph + 1 < hi) grid_bar(ldsb, WV); } } while (0)
#define DENSE_SCHED(S, nN_, Aptr, Bptr, lda_, ldb_) DenseSched S; S.o.init(T / 256, (nN_), F.G, F.bx); S.A = (const char*)(Aptr); S.B = (const char*)(Bptr); S.astep = (size_t)256 * (lda_) * 2; S.bstep = (size_t)256 * (ldb_) * 2
#define PLE_PROJ_GEMM(L_, dst, nwg_) do { int nl_, li_; light_cus(F, (nwg_), nl_, li_); if (li_ >= 0) { \
        DenseSched Sp; Sp.o.init(T / 256, DM / 256, nl_, li_); Sp.A = (const char*)(ws + WS_PB + (size_t)(L_) * T * PLE * 2); Sp.B = (const char*)((ws + WS_WPP) + (size_t)(L_) * DM * PLE * 2); Sp.astep = (size_t)256 * PLE * 2; Sp.bstep = (size_t)256 * PLE * 2; \
        pg8::EpiStore Ep{(bf16*)(dst), DM}; pg8::gemm_phase(ring, pg8::Gemm{PLE, PLE, PLE}, Sp, Ep, F.wave); } } while (0)
template <int j> __device__ __forceinline__ void layer_pair(LAS unsigned char* const ldsb, const int WV, unsigned char* const lds_raw) {
    {
        constexpr int L = 2 * j;
        PHASE(1, { DENSE_SCHED(S, INPROJ / 256, HB0, (ws + WS_WIN) + (size_t)j * INPROJ * DM * 2, DM, DM);
                   pg8::EpiInProj E{(bf16*)(ws + WS_Q), (bf16*)(ws + WS_K), (bf16*)(ws + WS_V), (bf16*)(ws + WS_G), RS0, (const float*)(ws + WS_ROPE), F.in[I_Q_NORM] + j * HD, F.in[I_K_NORM] + j * HD};
                   pg8::gemm_phase(ring, pg8::Gemm{DM, DM, DM}, S, E, F.wave);
                   PLE_PROJ_GEMM(L, ws + WS_PPLE_E, (T / 256) * (INPROJ / 256)); });
        PHASE(2, { const bool mem_first = false;
                   for (int u = F.vcu; u < 1024; u += F.G) { const int i = u >> 8, v = u & 255, grp = v >> 6, qb = v & 63;
                       attn_body::attn_unit<-1>(grp >> 1, (grp & 1) * 4 + i, qb, (const unsigned char*)(ws + WS_Q), (const unsigned char*)(ws + WS_K), (const unsigned char*)(ws + WS_V), (attn_body::bf16*)(ws + WS_MIX), (char*)lds_raw, F.wave); }
                   if (!mem_first) { conv_phase(F, j); if (j == 1) moe_convert(F, 1); } });
        PHASE(3, { { DENSE_SCHED(S, DM / 256, ws + WS_MIX, (ws + WS_WOUT) + (size_t)j * DM * DM * 2, DM, DM);
                     pg8::EpiResid E{HB0, RS1, dense_f8(j) ? (unsigned char*)(ws + WS_HQ) : nullptr};
                     pg8::gemm_phase(ring, pg8::Gemm{DM, DM, DM}, S, E, F.wave); }
                   });
        PHASE(4, { constexpr bool F8 = dense_f8(j); constexpr int KU = F8 ? DM / 2 : DM;
                   DENSE_SCHED(S, 2 * FFN / 256, F8 ? ws + WS_HQ : (unsigned char*)HB0, (ws + WS_WFGU) + (size_t)j * 2 * FFN * DM * 2, KU, KU);
                   pg8::EpiSwiGLU<false, F8> E{(bf16*)(ws + WS_FFNH), FFN, RS1};
                   pg8::gemm_phase<pg8::EpiSwiGLU<false, F8>, DenseSched, false, F8>(ring, pg8::Gemm{KU, KU, KU, 0x7F7F7F7F, F8 ? 0x79797979   : 0x7F7F7F7F}, S, E, F.wave); });
        PHASE(5, { constexpr bool F8 = dense_f8(j); constexpr int KD = F8 ? FFN / 2 : FFN;
                   DENSE_SCHED(S, DM / 256, ws + WS_FFNH, (ws + WS_WFD) + (size_t)j * DM * FFN * 2, KD, KD);
                   pg8::EpiResid E{HB0, RS0, nullptr};
                   pg8::gemm_phase<pg8::EpiResid, DenseSched, false, F8>(ring, pg8::Gemm{KD, KD, KD, F8 ? 0x7D7D7D7D   : 0x7F7F7F7F, F8 ? 0x79797979   : 0x7F7F7F7F}, S, E, F.wave); });
        PHASE(6, { DENSE_SCHED(S, DM / 256, HB0, (ws + WS_WPG) + (size_t)L * DM * DM * 2, DM, DM);
                   pg8::EpiPle<false> E{HB0, HB1, nullptr, RS1, RS0, (const bf16*)(ws + WS_PPLE_E)};
                   pg8::gemm_phase(ring, pg8::Gemm{DM, DM, DM}, S, E, F.wave); });
    }
    {
        constexpr int L = 2 * j + 1;
        PHASE(7, pool_stencil(F, HB1, RS1));
        PHASE(8, { PoolSched S; S.o.init(T / 256, 4, F.G, F.bx); S.A = (const char*)(ws + WS_YPOOL); S.B = (const char*)(ws + WS_WPOOL) + (size_t)j * 4 * 65536 * 2;
                   pg8::EpiResid E{HB1, RS0, (unsigned char*)(ws + WS_HQ)};
                   pg8::gemm_phase(ring, pg8::Gemm{DM, 256, 256}, S, E, F.wave); });
        PHASE(9, route_phase1(F, j, HB1));
        PHASE(10, route_phase2(F, j));
        PHASE(11, { MoeSched S; const int nrt = S.counts((const unsigned*)(ws + WS_CTL) + CW_CNT + 64 * j, (LAS int*)(F.lds + MISC_OFF + 64)); S.o.init(nrt, 2 * EXPD / 256, F.G, F.bx); S.A = (const char*)(ws + WS_HQ); S.B = (const char*)(ws + WS_WMGU);
                    S.astep = 0; S.wstride = (size_t)2 * EXPD * DM; S.bstep = (size_t)256 * DM; S.tmap = (const unsigned*)(ws + WS_TMAP); S.smap = (const float*)(ws + WS_SMAP);
                    pg8::EpiSwiGLU<true, true> E{(bf16*)(ws + WS_HID), EXPD, nullptr};
                    pg8::gemm_phase<pg8::EpiSwiGLU<true, true>, MoeSched, true, true>(ring, pg8::Gemm{DM / 2, DM / 2, DM / 2, 0x7F7F7F7F, 0x79797979  }, S, E, F.wave); });
        PHASE(12, { MoeSched S; const int nrt = S.counts((const unsigned*)(ws + WS_CTL) + CW_CNT + 64 * j, (LAS int*)(F.lds + MISC_OFF + 64)); S.o.init(nrt, DM / 256, F.G, F.bx); S.A = (const char*)(ws + WS_HID); S.B = (const char*)(ws + WS_WMD);
                    S.astep = (size_t)256 * EXPD; S.wstride = (size_t)DM * EXPD; S.bstep = (size_t)256 * EXPD; S.tmap = (const unsigned*)(ws + WS_TMAP); S.smap = (const float*)(ws + WS_SMAP);
                    pg8::EpiStore E{(bf16*)(ws + WS_XPERM), DM};
                    pg8::gemm_phase<pg8::EpiStore, MoeSched, false, true>(ring, pg8::Gemm{EXPD / 2, EXPD / 2, EXPD / 2, 0x7D7D7D7D  , 0x79797979  }, S, E, F.wave);
                    PLE_PROJ_GEMM(L, ws + WS_PPLE_O, nrt * (DM / 256)); });
        PHASE(13, combine_phase(F, j, HB1, RS1));
        PHASE(14, { DENSE_SCHED(S, DM / 256, HB1, (ws + WS_WPG) + (size_t)L * DM * DM * 2, DM, DM);
                    pg8::EpiPle<(j == 1)> E{HB1, HB0, F.out, RS0, RS1, (const bf16*)(ws + WS_PPLE_O)};
                    pg8::gemm_phase(ring, pg8::Gemm{DM, DM, DM}, S, E, F.wave); });
    }
}
__global__ void __launch_bounds__(NTHREADS, 2) fwd_kernel(Params P) {
    extern __shared__ __attribute__((aligned(16))) unsigned char lds_raw[];
    LAS unsigned char* const ldsb = (LAS unsigned char*)lds_raw;
    const int WV = __builtin_amdgcn_readfirstlane(threadIdx.x >> 6);
    for (int u = threadIdx.x; u < (LDS_BYTES - LDSCTL_OFF) / 4; u += NTHREADS) ((LAS unsigned*)(ldsb + LDSCTL_OFF))[u] = 0u;
    __syncthreads();
    { kparams_t kp = kparams(); if (kp->ph_hi - kp->ph_lo > 1) (void)xcd_barrier_post((unsigned*)(kp->ws + WS_CTL) + CW_BAR, (volatile LAS unsigned*)(ldsb + MISC_OFF) + 8, threadIdx.x == 0); }

    { const int j = 0; PHASE(0, p0_prologue(F)); }

    layer_pair<0>(ldsb, WV, lds_raw);
    layer_pair<1>(ldsb, WV, lds_raw);
}
#undef PHASE


extern "C" void kernel_launch(void* const* d_in, const int* in_sizes, int n_in, void* d_out, int out_size, void* d_ws, size_t ws_size, hipStream_t stream) {
    static int grid = 0;
    if (grid == 0) {
        if (n_in != 24 || in_sizes[0] != T * DM || out_size != T * DM || ws_size < WS_END) { fprintf(stderr, "kernel_launch: unexpected shapes (n_in %d, in0 %d, out %d, ws %zu < %zu); nothing launched\n", n_in, n_in > 0 ? in_sizes[0] : -1, out_size, ws_size, (size_t)WS_END); grid = -1; return; }
        int dev = 0, cus = 0, per_cu = 0;
        if (hipGetDevice(&dev) != hipSuccess || hipDeviceGetAttribute(&cus, hipDeviceAttributeMultiprocessorCount, dev) != hipSuccess) { grid = -1; return; }
        if (hipFuncSetAttribute((const void*)fwd_kernel, hipFuncAttributeMaxDynamicSharedMemorySize, LDS_BYTES) != hipSuccess) { fprintf(stderr, "kernel_launch: hipFuncSetAttribute failed\n"); grid = -1; return; }
        if (hipOccupancyMaxActiveBlocksPerMultiprocessor(&per_cu, (const void*)fwd_kernel, NTHREADS, LDS_BYTES) != hipSuccess || per_cu < 1) fprintf(stderr, "kernel_launch: occupancy query says %d\n", per_cu);
        (void)hipGetLastError();
        grid = cus;
    }
    if (grid < 0) return;
    (void)hipMemsetAsync((char*)d_ws + WS_CTL, 0, CTL_ZERO_BYTES, stream);
    Params p{};
    for (int i = 0; i < 24; ++i) p.in[i] = (const float*)d_in[i];
    p.out = (float*)d_out; p.ws = (unsigned char*)d_ws;
#if MK_ONE_LAUNCH
    p.ph_lo = 0; p.ph_hi = N_PHASES;
    hipLaunchKernelGGL(fwd_kernel, dim3(grid), dim3(NTHREADS), LDS_BYTES, stream, p);
#else
    for (int k = 0; k < N_PHASES; ++k) { p.ph_lo = k; p.ph_hi = k + 1; hipLaunchKernelGGL(fwd_kernel, dim3(grid), dim3(NTHREADS), LDS_BYTES, stream, p); }
#endif
    const hipError_t le = hipPeekAtLastError();
    if (le != hipSuccess) fprintf(stderr, "kernel_launch: launch failed: %s\n", hipGetErrorName(le));
}
```
